# Optimizing an MI355X kernel written in HIP

```python
import jax, jax.numpy as jnp
from jax import lax
import numpy as np

D_MODEL = 1024
BATCH = 4
SEQ = 8192
DEPTH = 1

D_RNN = 1024
RNN_BLOCKS = 8
RNN_BLOCK_W = D_RNN // RNN_BLOCKS
CONV_W = 4
LRU_C = 8.0
N_HEADS = 8
QK_NOPE = 128
QK_ROPE = 64
QK_DIM = QK_NOPE + QK_ROPE
V_DIM = 128
Q_LORA = 256
KV_LORA = 256
ROPE_THETA = 10000.0
Q_BLOCK = 128
N_GROUPS = 8
EXPERTS_PER_GROUP = 8
N_EXPERTS = N_GROUPS * EXPERTS_PER_GROUP
TOP_K = 2
D_EXPERT = 256
MOE_BLOCK = 128
EPS = 1e-6

IN_SPLITS = (D_RNN, D_RNN, Q_LORA, KV_LORA, QK_ROPE, D_MODEL, D_MODEL)
D_IN = D_RNN + D_RNN + Q_LORA + KV_LORA + QK_ROPE + D_MODEL + D_MODEL

kernel_name = "hybrid_rglru_mla_hiermoe_block"


def rmsnorm(x, g):
    xf = x.astype(jnp.float32)
    y = xf * lax.rsqrt(jnp.mean(xf * xf, axis=-1, keepdims=True) + EPS)
    return (y * g.astype(jnp.float32)).astype(x.dtype)


def causal_depthwise_conv(x, w, b):
    y = lax.conv_general_dilated(
        x, w[:, None, :].astype(x.dtype), window_strides=(1,),
        padding=[(CONV_W - 1, 0)], dimension_numbers=("NWC", "WIO", "NWC"),
        feature_group_count=x.shape[-1])
    return y + b.astype(x.dtype)


def rg_lru(x, wa, ba, wx, bx, lam):
    B, S, C = x.shape
    xb = x.reshape(B, S, RNN_BLOCKS, RNN_BLOCK_W)
    r = jax.nn.sigmoid(jnp.einsum("bsnk,nkj->bsnj", xb, wa).reshape(B, S, C) + ba)
    i = jax.nn.sigmoid(jnp.einsum("bsnk,nkj->bsnj", xb, wx).reshape(B, S, C) + bx)
    log_a = -LRU_C * r.astype(jnp.float32) * jax.nn.softplus(-lam.astype(jnp.float32))
    a = jnp.exp(log_a)
    mult = jnp.sqrt(-jnp.expm1(2.0 * log_a))
    b_in = x.astype(jnp.float32) * i.astype(jnp.float32) * mult

    def combine(left, right):
        a1, b1 = left
        a2, b2 = right
        return a1 * a2, a2 * b1 + b2

    _, h = lax.associative_scan(combine, (a, b_in), axis=1)
    return h.astype(x.dtype)


def apply_rope(x, cos, sin):
    half = x.shape[-1] // 2
    x1, x2 = x[..., :half], x[..., half:]
    return jnp.concatenate([x1 * cos - x2 * sin, x2 * cos + x1 * sin], axis=-1)


def mla_attention(c_q, c_kv, k_pe, positions, q_norm_g, w_uq, kv_norm_g, w_ukv,
                  qk_q_g, qk_k_g, w_mla_o):
    B, S, _ = c_q.shape
    q = (rmsnorm(c_q, q_norm_g) @ w_uq).reshape(B, S, N_HEADS, QK_DIM)
    kv = (rmsnorm(c_kv, kv_norm_g) @ w_ukv).reshape(B, S, N_HEADS, QK_NOPE + V_DIM)
    k_nope, v = kv[..., :QK_NOPE], kv[..., QK_NOPE:]
    k_pe_h = jnp.broadcast_to(k_pe[:, :, None, :], (B, S, N_HEADS, QK_ROPE))
    k = jnp.concatenate([k_nope, k_pe_h], axis=-1)
    q = rmsnorm(q, qk_q_g)
    k = rmsnorm(k, qk_k_g)
    inv_freq = ROPE_THETA ** (-jnp.arange(0, QK_ROPE, 2, dtype=jnp.float32) / QK_ROPE)
    ang = positions.astype(jnp.float32)[..., None] * inv_freq
    cos = jnp.cos(ang)[:, :, None, :].astype(q.dtype)
    sin = jnp.sin(ang)[:, :, None, :].astype(q.dtype)
    q = jnp.concatenate([q[..., :QK_NOPE], apply_rope(q[..., QK_NOPE:], cos, sin)], axis=-1)
    k = jnp.concatenate([k[..., :QK_NOPE], apply_rope(k[..., QK_NOPE:], cos, sin)], axis=-1)
    scale = QK_DIM ** -0.5
    outs = []
    for s0 in range(0, S, Q_BLOCK):
        e = s0 + Q_BLOCK
        s = jnp.einsum("bqhd,bkhd->bhqk", q[:, s0:e], k[:, :e]).astype(jnp.float32) * scale
        mask = jnp.arange(e)[None, :] <= (s0 + jnp.arange(Q_BLOCK))[:, None]
        p = jax.nn.softmax(jnp.where(mask, s, -jnp.inf), axis=-1).astype(v.dtype)
        outs.append(jnp.einsum("bhqk,bkhd->bqhd", p, v[:, :e]))
    o = jnp.concatenate(outs, axis=1).reshape(B, S, N_HEADS * V_DIM)
    return o @ w_mla_o


def hier_moe(u, wg, bg, we, be, w1, w3, w2):
    B, S, D = u.shape
    N = B * S
    xf = u.reshape(N, D)
    g_logits = (xf @ wg).astype(jnp.float32) + bg.astype(jnp.float32)
    g_prob = jax.nn.softmax(g_logits, axis=-1)
    g_sel = jnp.argmax(g_logits, axis=-1).astype(jnp.int32)
    e_logits = ((xf @ we).astype(jnp.float32) + be.astype(jnp.float32)).reshape(N, N_GROUPS, EXPERTS_PER_GROUP)
    e_in_group = jnp.take_along_axis(e_logits, g_sel[:, None, None], axis=1)[:, 0]
    e_prob = jax.nn.softmax(e_in_group, axis=-1)
    top_p, top_j = lax.top_k(e_prob, TOP_K)
    gate = jnp.take_along_axis(g_prob, g_sel[:, None], axis=1) * top_p / jnp.sum(top_p, axis=-1, keepdims=True)
    expert_id = g_sel[:, None] * EXPERTS_PER_GROUP + top_j.astype(jnp.int32)
    M = N * TOP_K
    flat_e = expert_id.reshape(M)
    flat_tok = jnp.repeat(jnp.arange(N, dtype=jnp.int32), TOP_K)
    flat_w = gate.reshape(M)
    order = jnp.argsort(flat_e)
    sorted_e = flat_e[order]
    counts = jnp.bincount(flat_e, length=N_EXPERTS)
    padded = ((counts + MOE_BLOCK - 1) // MOE_BLOCK) * MOE_BLOCK
    start = jnp.cumsum(counts) - counts
    pad_end = jnp.cumsum(padded)
    pad_start = pad_end - padded
    dest = pad_start[sorted_e] + (jnp.arange(M, dtype=jnp.int32) - start[sorted_e])
    m_pad = M + N_EXPERTS * MOE_BLOCK
    n_blocks = m_pad // MOE_BLOCK
    tok_buf = jnp.full((m_pad,), N, dtype=jnp.int32).at[dest].set(flat_tok[order])
    w_buf = jnp.zeros((m_pad,), dtype=jnp.float32).at[dest].set(flat_w[order])
    block_e = jnp.minimum(
        jnp.searchsorted(pad_end, jnp.arange(n_blocks, dtype=jnp.int32) * MOE_BLOCK, side="right"),
        N_EXPERTS - 1).astype(jnp.int32)
    x_pad = jnp.concatenate([xf, jnp.zeros((1, D), xf.dtype)], axis=0)[tok_buf]
    x_pad = x_pad.reshape(n_blocks, MOE_BLOCK, D)

    def expert_block(args):
        xb, e = args
        h = jax.nn.silu(xb @ w1[e]) * (xb @ w3[e])
        return h @ w2[e]

    y_pad = lax.map(expert_block, (x_pad, block_e)).reshape(m_pad, D)
    y = jax.ops.segment_sum(y_pad * w_buf[:, None].astype(y_pad.dtype), tok_buf, num_segments=N + 1)[:N]
    return y.reshape(B, S, D)


def setup_inputs(seed: int = 0) -> dict:
    key = jax.random.key(seed)
    ks = jax.random.split(key, 32)
    L, D, f32 = DEPTH, D_MODEL, jnp.float32

    def nrm(k, shape, fan_in):
        return jax.random.normal(k, shape, f32) * (fan_in ** -0.5)

    def gain(k, shape):
        return 1.0 + 0.1 * jax.random.normal(k, shape, f32)

    def bias(k, shape):
        return 0.01 * jax.random.normal(k, shape, f32)

    x = jax.random.normal(ks[0], (BATCH, SEQ, D), f32)
    offset = jax.random.randint(ks[1], (BATCH, 1), 0, 4096, dtype=jnp.int32)
    positions = offset + jnp.arange(SEQ, dtype=jnp.int32)[None, :]
    a0 = jax.random.uniform(ks[2], (L, D_RNN), f32, 0.9, 0.999)
    s0 = a0 ** (1.0 / LRU_C)
    lru_lambda = jnp.log(s0) - jnp.log1p(-s0)
    return {
        "x": x,
        "positions": positions,
        "norm1_g": gain(ks[3], (L, D)),
        "w_in": nrm(ks[4], (L, D, D_IN), D),
        "conv_w": nrm(ks[5], (L, CONV_W, D_RNN), CONV_W),
        "conv_b": bias(ks[6], (L, D_RNN)),
        "lru_wa": nrm(ks[7], (L, RNN_BLOCKS, RNN_BLOCK_W, RNN_BLOCK_W), RNN_BLOCK_W),
        "lru_ba": bias(ks[8], (L, D_RNN)),
        "lru_wx": nrm(ks[9], (L, RNN_BLOCKS, RNN_BLOCK_W, RNN_BLOCK_W), RNN_BLOCK_W),
        "lru_bx": bias(ks[10], (L, D_RNN)),
        "lru_lambda": lru_lambda,
        "w_rnn_o": nrm(ks[11], (L, D_RNN, D), D_RNN),
        "q_norm_g": gain(ks[12], (L, Q_LORA)),
        "w_uq": nrm(ks[13], (L, Q_LORA, N_HEADS * QK_DIM), Q_LORA),
        "kv_norm_g": gain(ks[14], (L, KV_LORA)),
        "w_ukv": nrm(ks[15], (L, KV_LORA, N_HEADS * (QK_NOPE + V_DIM)), KV_LORA),
        "qk_norm_q_g": gain(ks[16], (L, QK_DIM)),
        "qk_norm_k_g": gain(ks[17], (L, QK_DIM)),
        "w_mla_o": nrm(ks[18], (L, N_HEADS * V_DIM, D), N_HEADS * V_DIM),
        "w_out": nrm(ks[19], (L, D, D), D),
        "norm2_g": gain(ks[20], (L, D)),
        "router_wg": nrm(ks[21], (L, D, N_GROUPS), D),
        "router_bg": bias(ks[22], (L, N_GROUPS)),
        "router_we": nrm(ks[23], (L, D, N_EXPERTS), D),
        "router_be": bias(ks[24], (L, N_EXPERTS)),
        "exp_w1": nrm(ks[25], (L, N_EXPERTS, D, D_EXPERT), D),
        "exp_w3": nrm(ks[26], (L, N_EXPERTS, D, D_EXPERT), D),
        "exp_w2": nrm(ks[27], (L, N_EXPERTS, D_EXPERT, D), D_EXPERT),
    }


def reference(x, positions, norm1_g, w_in, conv_w, conv_b, lru_wa, lru_ba, lru_wx, lru_bx,
              lru_lambda, w_rnn_o, q_norm_g, w_uq, kv_norm_g, w_ukv, qk_norm_q_g, qk_norm_k_g,
              w_mla_o, w_out, norm2_g, router_wg, router_bg, router_we, router_be,
              exp_w1, exp_w3, exp_w2):
    split_points = [int(p) for p in np.cumsum(IN_SPLITS)[:-1]]
    h = x
    for l in range(DEPTH):
        u = rmsnorm(h, norm1_g[l])
        proj = u @ w_in[l]
        x_r, y_r, c_q, c_kv, k_pe, g_a, g_b = jnp.split(proj, split_points, axis=-1)
        x_r = causal_depthwise_conv(x_r, conv_w[l], conv_b[l])
        h_r = rg_lru(x_r, lru_wa[l], lru_ba[l], lru_wx[l], lru_bx[l], lru_lambda[l])
        branch_a = (h_r * jax.nn.gelu(y_r, approximate=True)) @ w_rnn_o[l]
        branch_b = mla_attention(c_q, c_kv, k_pe, positions, q_norm_g[l], w_uq[l], kv_norm_g[l],
                                 w_ukv[l], qk_norm_q_g[l], qk_norm_k_g[l], w_mla_o[l])
        merged = jax.nn.sigmoid(g_a) * branch_a + jax.nn.sigmoid(g_b) * branch_b
        h = h + merged @ w_out[l]
        h = h + hier_moe(rmsnorm(h, norm2_g[l]), router_wg[l], router_bg[l], router_we[l],
                         router_be[l], exp_w1[l], exp_w3[l], exp_w2[l])
    return h
```

```cpp
#include <hip/hip_runtime.h>
#include <hip/hip_cooperative_groups.h>
#include <cstdio>
#include <cstdint>
#include <cmath>
namespace cg = cooperative_groups;

constexpr int NB = 4, SEQ = 8192, DM = 1024, NTOK = NB * SEQ;
constexpr int NH = 8, QKD = 192, NOPE = 128, ROPE = 64, VD = 128;
constexpr int NE = 64, DE = 256;
constexpr int NP1 = 4864;
constexpr int MPAD = 81920;
constexpr float EPS = 1e-6f;
constexpr float QSCALE = 0.07216878364870322f * 1.4426950408889634f;

#define GAS __attribute__((address_space(1)))
#define LAS __attribute__((address_space(3)))
typedef unsigned short bf16_t;
typedef short bf16x8 __attribute__((ext_vector_type(8)));
typedef short s16x4 __attribute__((ext_vector_type(4)));
typedef float f32x4 __attribute__((ext_vector_type(4)));
typedef float f32x16 __attribute__((ext_vector_type(16)));
typedef unsigned u32x4 __attribute__((ext_vector_type(4)));
typedef unsigned u32x2 __attribute__((ext_vector_type(2)));
typedef float f32x2_t __attribute__((ext_vector_type(2)));
typedef __bf16 bf16x2_t __attribute__((ext_vector_type(2)));
typedef _Float16 f16x2_t __attribute__((ext_vector_type(2)));

__device__ __forceinline__ unsigned cvtpk(float lo, float hi) { f32x2_t v = {lo, hi}; bf16x2_t b = __builtin_convertvector(v, bf16x2_t); return __builtin_bit_cast(unsigned, b); }
__device__ __forceinline__ unsigned cvtpk_h(float lo, float hi) { f16x2_t v = {(_Float16)lo, (_Float16)hi}; return __builtin_bit_cast(unsigned, v); }
__device__ __forceinline__ float bflo(unsigned w) { return __uint_as_float(w << 16); }
__device__ __forceinline__ float bfhi(unsigned w) { return __uint_as_float(w & 0xffff0000u); }
__device__ __forceinline__ float hlo(unsigned w) { f16x2_t v = __builtin_bit_cast(f16x2_t, w); return (float)v[0]; }
__device__ __forceinline__ float hhi(unsigned w) { f16x2_t v = __builtin_bit_cast(f16x2_t, w); return (float)v[1]; }
__device__ __forceinline__ u32x4 pack8(f32x4 a, f32x4 b) { return (u32x4){cvtpk(a[0], a[1]), cvtpk(a[2], a[3]), cvtpk(b[0], b[1]), cvtpk(b[2], b[3])}; }
__device__ __forceinline__ void unpack8(u32x4 w, f32x4& a, f32x4& b) { a = (f32x4){bflo(w.x), bfhi(w.x), bflo(w.y), bfhi(w.y)}; b = (f32x4){bflo(w.z), bfhi(w.z), bflo(w.w), bfhi(w.w)}; }
__device__ __forceinline__ float sigmoidf_(float x) { return __builtin_amdgcn_rcpf(1.0f + __builtin_amdgcn_exp2f(-1.4426950408889634f * x)); }
__device__ __forceinline__ float gelu_tanh(float x) { const float u = 1.5957691216057308f * (x + 0.044715f * x * x * x); return x * __builtin_amdgcn_rcpf(1.0f + __builtin_amdgcn_exp2f(-1.4426950408889634f * u)); }
__device__ __forceinline__ float wave_sum(float v) {
#pragma unroll
    for (int o = 1; o < 64; o <<= 1) v += __shfl_xor(v, o);
    return v;
}
#define LDS_WAIT() asm volatile("s_waitcnt lgkmcnt(0)" ::: "memory")

constexpr size_t MiB = 1u << 20;
constexpr size_t WS_CTL = 0, CTL_ZERO_BYTES = 8192;
constexpr size_t WS_C8 = 512 * 1024, WS_WR = WS_C8 + 4096, WS_BR = WS_WR + 1024 * 72 * 4;
constexpr size_t WS_WIN = 1 * MiB, WS_WRNN = WS_WIN + (size_t)NP1 * 1024 * 2, WS_WMLA = WS_WRNN + 2 * MiB, WS_WOUT = WS_WMLA + 2 * MiB,
                 WS_WUQ = WS_WOUT + 2 * MiB, WS_WUKV = WS_WUQ + 1 * MiB, WS_WGATE = WS_WUKV + 1 * MiB, WS_WEND = WS_WGATE + 1 * MiB;
constexpr size_t S0 = 20 * MiB, S1 = 84 * MiB, S2 = 148 * MiB, S3 = 212 * MiB, S4 = 276 * MiB, S5 = 340 * MiB, S6 = 404 * MiB, ST = 468 * MiB;
static_assert(WS_WEND <= S0, "weights fit below the slots");
constexpr size_t WS_U = S0, WS_XR = S1, WS_GY = S2, WS_SGA = S3, WS_SGB = S4, WS_XC = S5, WS_CQN = S6, WS_CKVN = S6 + 16 * MiB;
constexpr size_t WS_CQ = ST, WS_CKV = ST + 16 * MiB, WS_KPE = ST + 32 * MiB, WS_SUMM = ST + 36 * MiB, WS_REC = ST + 38 * MiB, WS_TOKPOS = ST + 39 * MiB, WS_GATEPOS = WS_TOKPOS + 512 * 1024;
constexpr size_t WS_LOGA = S0, WS_BIN = S1, WS_Z = S1;
constexpr size_t WS_KN = S2, WS_V = S0, WS_KR = S5, WS_O = S6;
constexpr size_t WS_AOUT = S5, WS_MERGED = S0;
constexpr size_t WS_U2 = S1, WS_W13 = S2, WS_W2 = S3, WS_XS = S4, WS_YS = S4, WS_HS = S0;
constexpr size_t WS_NEED = 512 * MiB;
static_assert(WS_GATEPOS + (size_t)MPAD * 4 <= WS_NEED && WS_XS + (size_t)MPAD * 2048 <= ST, "workspace map");

constexpr int RING_BYTES = 131072;
constexpr int L_TILE_E = RING_BYTES, L_PADSTART = L_TILE_E + 2048, L_TT = L_PADSTART + 256, L_LG = RING_BYTES + 4096;
constexpr int LDS_BYTES = 147456;
static_assert(L_LG + 32 * 72 * 4 <= LDS_BYTES, "LDS map");

struct Args { const void* in[28]; float* out; unsigned char* ws; float invf[32]; int ph_lo, ph_hi; };

struct Frame {
    LAS unsigned char* lds; unsigned char* ws; float* out;
    int tid, lane, wave, vcu, G, gw, NGW;
};
namespace pg8 {
#define PG8_LAS __attribute__((address_space(3)))
typedef unsigned short bf16_t;
typedef short bf16x8 __attribute__((ext_vector_type(8)));
typedef float f32x4 __attribute__((ext_vector_type(4)));
typedef unsigned u32x4 __attribute__((ext_vector_type(4)));
constexpr int BM = 256, BK = 64, HALF = 128, HTB = HALF * BK * 2  , STAGE_BYTES = 8 * HTB, NXCD = 8, WGM = 8;

__host__ __device__ __forceinline__ int lds_byte(int r, int c) { const int st = (r >> 4) * 2 + (c >> 5), rr = r & 15, cc = c & 31, ob = rr * 64 + cc * 2; return st * 1024 + (ob ^ (((ob >> 9) & 1) << 5)); }
__host__ __device__ __forceinline__ void stage_rc(int b, int& R, int& C) { const int st = b / 1024, sb = b % 1024, swz = sb ^ (((sb >> 9) & 1) << 5); R = (st >> 1) * 16 + swz / 64; C = (st & 1) * 32 + (swz % 64) / 2; }
__host__ __device__ __forceinline__ int perm32(int rho) { const int n = rho >> 4, i = rho & 15; return 8 * (i >> 2) + 4 * n + (i & 3); }

struct Unit { int pm, pn, ex; };
struct Gemm { const char* A; const char* B; unsigned lda, ldb; int K; };
__device__ __forceinline__ unsigned cvt_pk_bf16(float lo, float hi) { unsigned r; asm volatile("v_cvt_pk_bf16_f32 %0, %1, %2" : "=v"(r) : "v"(lo), "v"(hi)); return r; }
template <class Epi, class Sched, bool ALIGN_EPI = false, bool SP2 = false>
__device__ __forceinline__ void gemm_phase(PG8_LAS unsigned char* lds, const Gemm g, const Sched& S, const Epi& E) {
    const int tid = threadIdx.x, wid = __builtin_amdgcn_readfirstlane(tid >> 6), lane = tid & 63, wr = wid >> 2, wc = wid & 3, fr = lane & 15, fq = lane >> 4;
    const int K = g.K, nt = K / BK;
    unsigned voffA[2], voffB[2];
#pragma unroll
    for (int i = 0; i < 2; ++i) { int R, C; stage_rc(tid * 16 + i * 8192, R, C); const int Rb = Epi::PERM ? ((R & ~31) + perm32(R & 31)) : R;
        voffA[i] = (unsigned)R * g.lda + (unsigned)C * 2u; voffB[i] = (unsigned)Rb * g.ldb + (unsigned)C * 2u; }
    const size_t kstep = (size_t)(BK * 2);
    const size_t hstepA = (size_t)HALF * g.lda, hstepB = (size_t)HALF * g.ldb;
    const unsigned ldsw = (unsigned)wid * 1024u;
    const int aoff = lds_byte(wr * 64 + fr, fq * 8), boff = lds_byte(wc * 32 + fr, fq * 8);
#define PG8_SA(b, h) (((b) * 2 + (h)) * HTB)
#define PG8_SB(b, h) ((4 + (b) * 2 + (h)) * HTB)
#define PG8_STAGE(bufoff, gbase, voff) do { _Pragma("unroll") for (int _i = 0; _i < 2; ++_i) \
        __builtin_amdgcn_global_load_lds((const unsigned*)((const char*)(gbase) + (voff)[_i]), (PG8_LAS unsigned*)(lds + (bufoff) + ldsw + _i * 8192), 16, 0, 0); } while (0)
#define PG8_LDA(dst, b, h) do { _Pragma("unroll") for (int m = 0; m < 4; ++m) _Pragma("unroll") for (int k = 0; k < 2; ++k) dst[m][k] = *(const PG8_LAS bf16x8*)(lds + PG8_SA(b, h) + aoff + m * 2048 + k * 1024); } while (0)
#define PG8_LDB(dst, b, h) do { _Pragma("unroll") for (int n = 0; n < 2; ++n) _Pragma("unroll") for (int k = 0; k < 2; ++k) dst[n][k] = *(const PG8_LAS bf16x8*)(lds + PG8_SB(b, h) + boff + n * 2048 + k * 1024); } while (0)
#define PG8_MMA(ai, bj, At, Bt) do { __builtin_amdgcn_s_setprio(1); _Pragma("unroll") for (int m = 0; m < 4; ++m) _Pragma("unroll") for (int n = 0; n < 2; ++n) _Pragma("unroll") for (int k = 0; k < 2; ++k) \
        acc[ai][bj][m][n] = __builtin_amdgcn_mfma_f32_16x16x32_bf16(Bt[n][k], At[m][k], acc[ai][bj][m][n], 0, 0, 0); __builtin_amdgcn_s_setprio(0); } while (0)
#define PG8_WAIT_V(n) asm volatile("s_waitcnt vmcnt(" #n ")" ::: "memory")
#define PG8_WAIT_L(n) asm volatile("s_waitcnt lgkmcnt(" #n ")" ::: "memory")
#define PG8_BAR __builtin_amdgcn_s_barrier()
#define PG8_SCHED __builtin_amdgcn_sched_barrier(0)
    Unit cur, nxt; int ui = 0;
    if (!S.next(0, cur)) return;
    f32x4 acc[2][2][4][2];
#pragma unroll
    for (int a = 0; a < 2; ++a)
#pragma unroll
        for (int b = 0; b < 2; ++b)
#pragma unroll
            for (int m = 0; m < 4; ++m)
#pragma unroll
                for (int n = 0; n < 2; ++n) acc[a][b][m][n] = (f32x4){0.f, 0.f, 0.f, 0.f};
    bf16x8 At[4][2], B0[2][2], B1[2][2];
    const char* cA = g.A + S.aoff(cur); const char* cB = g.B + S.boff(cur);
    S.a_ready(cur);
    if constexpr (SP2) {
        PG8_STAGE(PG8_SB(0, 0), cB, voffB); PG8_STAGE(PG8_SB(0, 1), cB + hstepB, voffB); PG8_STAGE(PG8_SA(0, 0), cA, voffA); PG8_STAGE(PG8_SA(0, 1), cA + hstepA, voffA);
        if (wr == 1) PG8_BAR;
        PG8_WAIT_V(2); PG8_BAR;
        PG8_STAGE(PG8_SB(1, 0), cB + kstep, voffB); PG8_STAGE(PG8_SA(1, 0), cA + kstep, voffA); PG8_STAGE(PG8_SB(1, 1), cB + hstepB + kstep, voffB);
        PG8_WAIT_V(6); PG8_BAR;
    } else {
        PG8_STAGE(PG8_SB(0, 0), cB, voffB); PG8_STAGE(PG8_SA(0, 0), cA, voffA); PG8_STAGE(PG8_SB(0, 1), cB + hstepB, voffB); PG8_STAGE(PG8_SA(0, 1), cA + hstepA, voffA);
        if (wr == 1) PG8_BAR;
        PG8_WAIT_V(4); PG8_BAR;
        PG8_STAGE(PG8_SB(1, 0), cB + kstep, voffB); PG8_STAGE(PG8_SA(1, 0), cA + kstep, voffA); PG8_STAGE(PG8_SB(1, 1), cB + hstepB + kstep, voffB);
        PG8_WAIT_V(6); PG8_BAR;
    }
    for (;;) {
        const bool has_next = S.next(ui + 1, nxt);
        const char* nA = has_next ? g.A + S.aoff(nxt) : cA; const char* nB = has_next ? g.B + S.boff(nxt) : cB;
#pragma unroll 1
        for (int t = 0; t < nt; t += 2) {
            const bool last = (t == nt - 2);
            const char* a1 = cA + (size_t)(t + 1) * kstep;
            const char* a2 = last ? nA : cA + (size_t)(t + 2) * kstep; const char* b2 = last ? nB : cB + (size_t)(t + 2) * kstep;
            const char* a3 = a2 + kstep; const char* b3 = b2 + kstep;
            if (last && has_next) S.a_ready(nxt);
            if constexpr (SP2) {
            PG8_LDB(B0, 0, 0); PG8_LDB(B1, 0, 1); PG8_SCHED; PG8_LDA(At, 0, 0); PG8_STAGE(PG8_SA(1, 1), a1 + hstepA, voffA);
            PG8_WAIT_V(8); PG8_WAIT_L(0); PG8_BAR; PG8_MMA(0, 0, At, B0); PG8_MMA(0, 1, At, B1); PG8_BAR; PG8_SCHED;
            PG8_LDA(At, 0, 1); PG8_STAGE(PG8_SB(0, 0), b2, voffB); PG8_STAGE(PG8_SB(0, 1), b2 + hstepB, voffB); PG8_STAGE(PG8_SA(0, 0), a2, voffA);
            PG8_WAIT_V(8); PG8_WAIT_L(0); PG8_BAR; PG8_MMA(1, 0, At, B0); PG8_MMA(1, 1, At, B1); PG8_BAR; PG8_SCHED;
            PG8_LDB(B0, 1, 0); PG8_LDB(B1, 1, 1); PG8_SCHED; PG8_LDA(At, 1, 0); PG8_STAGE(PG8_SA(0, 1), a2 + hstepA, voffA);
            PG8_WAIT_V(8); PG8_WAIT_L(0); PG8_BAR; PG8_MMA(0, 0, At, B0); PG8_MMA(0, 1, At, B1); PG8_BAR; PG8_SCHED;
            PG8_LDA(At, 1, 1); PG8_STAGE(PG8_SB(1, 0), b3, voffB); PG8_STAGE(PG8_SB(1, 1), b3 + hstepB, voffB); PG8_STAGE(PG8_SA(1, 0), a3, voffA);
            PG8_WAIT_V(8); PG8_WAIT_L(0); PG8_BAR; PG8_MMA(1, 0, At, B0); PG8_MMA(1, 1, At, B1); PG8_BAR; PG8_SCHED;
            } else {
            PG8_LDB(B0, 0, 0); PG8_SCHED; PG8_LDA(At, 0, 0); PG8_STAGE(PG8_SA(1, 1), a1 + hstepA, voffA);
            PG8_WAIT_L(8); PG8_BAR; PG8_WAIT_L(0); PG8_MMA(0, 0, At, B0); PG8_BAR; PG8_SCHED;
            PG8_LDB(B1, 0, 1); PG8_STAGE(PG8_SB(0, 0), b2, voffB);
            PG8_BAR; PG8_WAIT_L(0); PG8_MMA(0, 1, At, B1); PG8_BAR;
            PG8_LDA(At, 0, 1); PG8_STAGE(PG8_SA(0, 0), a2, voffA);
            PG8_BAR; PG8_WAIT_L(0); PG8_MMA(1, 0, At, B0); PG8_BAR; PG8_SCHED;
            PG8_STAGE(PG8_SB(0, 1), b2 + hstepB, voffB);
            PG8_WAIT_V(6); PG8_BAR; PG8_MMA(1, 1, At, B1); PG8_BAR;
            PG8_LDB(B0, 1, 0); PG8_SCHED; PG8_LDA(At, 1, 0); PG8_STAGE(PG8_SA(0, 1), a2 + hstepA, voffA);
            PG8_WAIT_L(8); PG8_BAR; PG8_WAIT_L(0); PG8_MMA(0, 0, At, B0); PG8_BAR; PG8_SCHED;
            PG8_LDB(B1, 1, 1); PG8_STAGE(PG8_SB(1, 0), b3, voffB);
            PG8_BAR; PG8_WAIT_L(0); PG8_MMA(0, 1, At, B1); PG8_BAR;
            PG8_LDA(At, 1, 1); PG8_STAGE(PG8_SA(1, 0), a3, voffA);
            PG8_BAR; PG8_WAIT_L(0); PG8_MMA(1, 0, At, B0); PG8_BAR; PG8_SCHED;
            PG8_STAGE(PG8_SB(1, 1), b3 + hstepB, voffB);
            PG8_WAIT_V(6); PG8_BAR; PG8_MMA(1, 1, At, B1); PG8_BAR;
            }
        }
        if constexpr (ALIGN_EPI) { if (wr == 0) PG8_BAR; }
        if constexpr (!Epi::AFTER_DRAIN) { E(acc, cur, wr, wc, fr, fq); S.done(cur); }
        if (!has_next) break;
#pragma unroll
        for (int a = 0; a < 2; ++a)
#pragma unroll
            for (int b = 0; b < 2; ++b)
#pragma unroll
                for (int m = 0; m < 4; ++m)
#pragma unroll
                    for (int n = 0; n < 2; ++n) acc[a][b][m][n] = (f32x4){0.f, 0.f, 0.f, 0.f};
        cur = nxt; cA = nA; cB = nB; ++ui;
        if constexpr (ALIGN_EPI) { if (wr == 1) PG8_BAR; }
    }
    PG8_WAIT_V(0);
    if constexpr (!ALIGN_EPI) { if (wr == 0) PG8_BAR; }
    PG8_BAR;
    if constexpr (Epi::AFTER_DRAIN) { E.fused(acc, cur, wr, wc, fr, fq, lds, wid, lane); S.done(cur); }
#undef PG8_SA
#undef PG8_SB
#undef PG8_STAGE
#undef PG8_LDA
#undef PG8_LDB
#undef PG8_MMA
#undef PG8_WAIT_V
#undef PG8_WAIT_L
#undef PG8_BAR
#undef PG8_SCHED
}
}

namespace pg8 {
struct GridOrder {
    int nM, nN, nwg, G, c, a_sh; size_t a_sm, a_sn, b_sn;
    __device__ __forceinline__ void init(int nM_, int nN_, int G_, int c_, size_t a_sm_, int a_sh_, size_t a_sn_, size_t b_sn_) { nM = nM_; nN = nN_; nwg = nM * nN; G = G_; c = c_; a_sm = a_sm_; a_sh = a_sh_; a_sn = a_sn_; b_sn = b_sn_; }
    __device__ __forceinline__ bool next(int i, Unit& u) const {
        const long L = (long)i * G + c; if (L >= nwg) return false;
        int wgid = (int)L; { const int q = nwg / NXCD, r = nwg % NXCD, xcd = wgid % NXCD, off = wgid / NXCD; wgid = (xcd < r ? xcd * (q + 1) : r * (q + 1) + (xcd - r) * q) + off; }
        const int nig = WGM * nN, gid = wgid / nig, fm = gid * WGM, gsz = (nM - fm) < WGM ? (nM - fm) : WGM;
        u.pm = fm + ((wgid % nig) % gsz); u.pn = (wgid % nig) / gsz; u.ex = 0; return true;
    }
    __device__ __forceinline__ size_t aoff(const Unit& u) const { return (size_t)u.pm * a_sm + (size_t)(u.pn >> a_sh) * a_sn; }
    __device__ __forceinline__ size_t boff(const Unit& u) const { return (size_t)u.pn * b_sn; }
    __device__ __forceinline__ void a_ready(const Unit&) const {}
    __device__ __forceinline__ void done(const Unit&) const {}
};
struct MoeOrder {
    int total, G, c, nsub; const PG8_LAS int* tile_e; size_t a_sm, b_se, b_sn;
    __device__ __forceinline__ bool next(int i, Unit& u) const {
        const long L = (long)i * G + c; if (L >= total) return false;
        const int rt = (int)L / nsub; u.pm = rt; u.pn = (int)L - rt * nsub; u.ex = __builtin_amdgcn_readfirstlane(tile_e[rt]); return true;
    }
    __device__ __forceinline__ size_t aoff(const Unit& u) const { return (size_t)u.pm * a_sm; }
    __device__ __forceinline__ size_t boff(const Unit& u) const { return (size_t)u.ex * b_se + (size_t)u.pn * b_sn; }
    __device__ __forceinline__ void a_ready(const Unit&) const {}
    __device__ __forceinline__ void done(const Unit&) const {}
};

#define EPI_FOR_AI_M  _Pragma("unroll") for (int ai = 0; ai < 2; ++ai) _Pragma("unroll") for (int m = 0; m < 4; ++m)
#define EPI_ROW (u.pm * BM + ai * HALF + wr * 64 + m * 16 + fr)

struct EpiP1 {
    static constexpr bool PERM = true, AFTER_DRAIN = false;
    bf16_t *XR, *GY, *CQ, *CKV, *KPE, *SGA, *SGB;
    __device__ __forceinline__ void operator()(const f32x4 (&acc)[2][2][4][2], const Unit& u, int wr, int wc, int fr, int fq) const {
        const int pn = u.pn; bf16_t* base; int ld, colt, act = 0, climit = 256;
        if (pn < 4) { base = XR; ld = 1024; colt = pn * 256; }
        else if (pn < 8) { base = GY; ld = 1024; colt = (pn - 4) * 256; act = 1; }
        else if (pn == 8) { base = CQ; ld = 256; colt = 0; }
        else if (pn == 9) { base = CKV; ld = 256; colt = 0; }
        else if (pn == 10) { base = KPE; ld = 64; colt = 0; climit = 64; }
        else if (pn < 15) { base = SGA; ld = 1024; colt = (pn - 11) * 256; act = 2; }
        else { base = SGB; ld = 1024; colt = (pn - 15) * 256; act = 2; }
        EPI_FOR_AI_M { const size_t row = EPI_ROW;
#pragma unroll
            for (int bj = 0; bj < 2; ++bj) { const int c = bj * HALF + wc * 32 + 8 * fq; f32x4 v0 = acc[ai][bj][m][0], v1 = acc[ai][bj][m][1];
                if (act == 1) { _Pragma("unroll") for (int j = 0; j < 4; ++j) { v0[j] = gelu_tanh(v0[j]); v1[j] = gelu_tanh(v1[j]); } }
                else if (act == 2) { _Pragma("unroll") for (int j = 0; j < 4; ++j) { v0[j] = sigmoidf_(v0[j]); v1[j] = sigmoidf_(v1[j]); } }
                if (c < climit) *(u32x4*)(base + row * ld + colt + c) = pack8(v0, v1); } }
    }
};
struct EpiGates {
    static constexpr bool PERM = true, AFTER_DRAIN = false;
    const bf16_t* XC; const float *ba, *bx, *c8; bf16_t* LOGA; bf16_t* BIN;
    __device__ __forceinline__ void operator()(const f32x4 (&acc)[2][2][4][2], const Unit& u, int wr, int wc, int fr, int fq) const {
        const int ch = u.pn * 128 + wc * 32 + 8 * fq;
#pragma unroll
        for (int n = 0; n < 2; ++n) { const f32x4 br = *(const f32x4*)(ba + ch + 4 * n), bi = *(const f32x4*)(bx + ch + 4 * n), cc = *(const f32x4*)(c8 + ch + 4 * n);
            EPI_FOR_AI_M { const size_t off = (size_t)EPI_ROW * 1024 + ch + 4 * n;
                const u32x2 xw = *(const u32x2*)(XC + off); const f32x4 xv = {bflo(xw.x), bfhi(xw.x), bflo(xw.y), bfhi(xw.y)};
                f32x4 la, bb;
#pragma unroll
                for (int j = 0; j < 4; ++j) { const float r = sigmoidf_(acc[ai][0][m][n][j] + br[j]), ig = sigmoidf_(acc[ai][1][m][n][j] + bi[j]); const float l = -cc[j] * r;
                    const float t = 2.0f * l;
                    const float em = -t * (1.0f + t * (0.5f + t * (0.16666667f + t * (0.041666668f + t * (0.0083333338f + t * 0.0013888889f)))));
                    la[j] = l; bb[j] = xv[j] * ig * __builtin_amdgcn_sqrtf(fmaxf(em, 0.0f)); }
                *(u32x2*)(LOGA + off) = (u32x2){cvtpk_h(la[0], la[1]), cvtpk_h(la[2], la[3])};
                *(u32x2*)(BIN + off) = (u32x2){cvtpk(bb[0], bb[1]), cvtpk(bb[2], bb[3])}; } }
    }
};
struct EpiQ {
    static constexpr bool PERM = true, AFTER_DRAIN = false;
    bf16_t* Q;
    __device__ __forceinline__ void operator()(const f32x4 (&acc)[2][2][4][2], const Unit& u, int wr, int wc, int fr, int fq) const {
        EPI_FOR_AI_M { const size_t row = EPI_ROW;
#pragma unroll
            for (int bj = 0; bj < 2; ++bj) { const int c = bj * HALF + wc * 32 + 8 * fq;
                if (c < QKD) *(u32x4*)(Q + row * (NH * QKD) + u.pn * QKD + c) = pack8(acc[ai][bj][m][0], acc[ai][bj][m][1]); } }
    }
};
struct EpiKV {
    static constexpr bool PERM = true, AFTER_DRAIN = false;
    bf16_t *KN, *V;
    __device__ __forceinline__ void operator()(const f32x4 (&acc)[2][2][4][2], const Unit& u, int wr, int wc, int fr, int fq) const {
        EPI_FOR_AI_M { const size_t off = (size_t)EPI_ROW * 1024 + u.pn * 128 + wc * 32 + 8 * fq;
            *(u32x4*)(KN + off) = pack8(acc[ai][0][m][0], acc[ai][0][m][1]);
            *(u32x4*)(V + off) = pack8(acc[ai][1][m][0], acc[ai][1][m][1]); }
    }
};
struct EpiPlain {
    static constexpr bool PERM = true, AFTER_DRAIN = false;
    bf16_t* O; int ldc;
    __device__ __forceinline__ void operator()(const f32x4 (&acc)[2][2][4][2], const Unit& u, int wr, int wc, int fr, int fq) const {
        EPI_FOR_AI_M { const size_t row = EPI_ROW;
#pragma unroll
            for (int bj = 0; bj < 2; ++bj) *(u32x4*)(O + row * ldc + u.pn * BM + bj * HALF + wc * 32 + 8 * fq) = pack8(acc[ai][bj][m][0], acc[ai][bj][m][1]); }
    }
};
struct EpiMerge {
    static constexpr bool PERM = true, AFTER_DRAIN = false;
    const bf16_t *SGA, *SGB, *AOUT; bf16_t* MG;
    __device__ __forceinline__ void operator()(const f32x4 (&acc)[2][2][4][2], const Unit& u, int wr, int wc, int fr, int fq) const {
        EPI_FOR_AI_M { const size_t row = EPI_ROW;
#pragma unroll
            for (int bj = 0; bj < 2; ++bj) { const size_t off = row * 1024 + u.pn * BM + bj * HALF + wc * 32 + 8 * fq;
                f32x4 a0, a1, g0, g1, s0, s1; unpack8(*(const u32x4*)(AOUT + off), a0, a1); unpack8(*(const u32x4*)(SGA + off), g0, g1); unpack8(*(const u32x4*)(SGB + off), s0, s1);
                *(u32x4*)(MG + off) = pack8(g0 * a0 + s0 * acc[ai][bj][m][0], g1 * a1 + s1 * acc[ai][bj][m][1]); } }
    }
};
struct EpiResF32 {
    static constexpr bool PERM = false, AFTER_DRAIN = false;
    const float* X; float* H;
    __device__ __forceinline__ void operator()(const f32x4 (&acc)[2][2][4][2], const Unit& u, int wr, int wc, int fr, int fq) const {
        EPI_FOR_AI_M { const size_t row = EPI_ROW;
#pragma unroll
            for (int bj = 0; bj < 2; ++bj)
#pragma unroll
                for (int n = 0; n < 2; ++n) { const size_t off = row * 1024 + u.pn * BM + bj * HALF + wc * 32 + 16 * n + 4 * fq;
                    *(f32x4*)(H + off) = *(const f32x4*)(X + off) + acc[ai][bj][m][n]; } }
    }
};
struct EpiUp {
    static constexpr bool PERM = true, AFTER_DRAIN = false;
    bf16_t* HS;
    __device__ __forceinline__ void operator()(const f32x4 (&acc)[2][2][4][2], const Unit& u, int wr, int wc, int fr, int fq) const {
        EPI_FOR_AI_M { const size_t off = (size_t)EPI_ROW * DE + u.pn * 128 + wc * 32 + 8 * fq;
            f32x4 h0, h1;
#pragma unroll
            for (int j = 0; j < 4; ++j) { const float a0 = acc[ai][0][m][0][j], a1 = acc[ai][0][m][1][j]; h0[j] = a0 * sigmoidf_(a0) * acc[ai][1][m][0][j]; h1[j] = a1 * sigmoidf_(a1) * acc[ai][1][m][1][j]; }
            *(u32x4*)(HS + off) = pack8(h0, h1); }
    }
};
struct EpiDown {
    static constexpr bool PERM = true, AFTER_DRAIN = false;
    bf16_t* YS; const float* gate;
    __device__ __forceinline__ void operator()(const f32x4 (&acc)[2][2][4][2], const Unit& u, int wr, int wc, int fr, int fq) const {
        EPI_FOR_AI_M { const size_t row = EPI_ROW; const float g = gate[row];
#pragma unroll
            for (int bj = 0; bj < 2; ++bj) *(u32x4*)(YS + row * 1024 + u.pn * BM + bj * HALF + wc * 32 + 8 * fq) = pack8(acc[ai][bj][m][0] * g, acc[ai][bj][m][1] * g); }
    }
};
#undef EPI_FOR_AI_M
#undef EPI_ROW
}

namespace att {
constexpr int SHM_V = 16384, SHM_KN = 16384, SHM_KR = 8192;
constexpr int OFF_V = 0, OFF_KN = 2 * SHM_V, OFF_KR = OFF_KN + 2 * SHM_KN, OFF_WS = OFF_KR + 2 * SHM_KR, ATT_LDS = OFF_WS + 8 * 64 * 4;
constexpr float THR = 8.0f;
#define KSWZ(row, colB) ((row) * 256 + ((colB) ^ (((row) & 7) << 4)))
#define KRSWZ(row, ch) (((row) >> 1) * 256 + (((((row) & 1) << 3) + (ch)) ^ (((row) >> 1) & 7)) * 16)
#define SBAR() __builtin_amdgcn_sched_barrier(0)
__device__ __forceinline__ int v_st(int k, int c) { const int kk = (k & ~0xC) | ((k & 4) << 1) | ((k & 8) >> 1); return ((kk >> 3) * 4 + (c >> 5)) * 512 + ((kk & 7) * 32 + (c & 31)) * 2; }
__device__ __forceinline__ int v_rd_base(int lane) { return ((lane & 3) << 3) | (((lane >> 2) & 3) << 6) | (((lane >> 4) & 1) << 5) | (((lane >> 5) & 1) << 8); }
constexpr int v_rd_off(int d0, int ks, int half) { return d0 * 512 + ks * 4096 + half * 2048; }
__device__ __forceinline__ int crow(int r, int hi) { return (r & 3) + 8 * (r >> 2) + 4 * hi; }
__device__ __forceinline__ unsigned cvtpk_a(float lo, float hi) { unsigned r; asm volatile("v_cvt_pk_bf16_f32 %0, %1, %2" : "=v"(r) : "v"(lo), "v"(hi)); return r; }

__device__ __forceinline__ void mask_tile(f32x16& p0, f32x16& p1, int dq) {
    const float NEG = -__builtin_inff();
#pragma unroll
    for (int r = 0; r < 16; ++r) {
        const int c = (r & 3) + 8 * (r >> 2);
        if (dq - c < 0) p0[r] = NEG;
        if (dq - c - 32 < 0) p1[r] = NEG;
    }
}
__device__ __forceinline__ void partialSM(f32x16& p0, f32x16& p1, float& m_reg, float& alpha) {
    float pmax = p0[0];
#pragma unroll
    for (int r = 1; r < 16; ++r) pmax = fmaxf(pmax, p0[r]);
#pragma unroll
    for (int r = 0; r < 16; ++r) pmax = fmaxf(pmax, p1[r]);
    { auto rr = __builtin_amdgcn_permlane32_swap(__float_as_uint(pmax), __float_as_uint(pmax), false, false);
      pmax = fmaxf(__uint_as_float(rr[0]), __uint_as_float(rr[1])); }
    float mn;
    if (__builtin_expect(__all((pmax - m_reg) <= THR), 1)) { mn = m_reg; alpha = 1.f; }
    else { mn = fmaxf(m_reg, pmax); alpha = __builtin_amdgcn_exp2f(m_reg - mn); m_reg = mn; }
#pragma unroll
    for (int r = 0; r < 16; ++r) p0[r] = __builtin_amdgcn_exp2f(p0[r] - mn);
#pragma unroll
    for (int r = 0; r < 16; ++r) p1[r] = __builtin_amdgcn_exp2f(p1[r] - mn);
}
__device__ __forceinline__ void finishSM(f32x16& p0, f32x16& p1, float alpha, float& l_reg, bf16x8& pa0, bf16x8& pa1, bf16x8& pa2, bf16x8& pa3) {
    float ps = 0;
#pragma unroll
    for (int r = 0; r < 16; ++r) ps += p0[r];
#pragma unroll
    for (int r = 0; r < 16; ++r) ps += p1[r];
    { auto rr = __builtin_amdgcn_permlane32_swap(__float_as_uint(ps), __float_as_uint(ps), false, false);
      ps = __uint_as_float(rr[0]) + __uint_as_float(rr[1]); }
    l_reg = l_reg * alpha + ps;
#define PK4(P, B_, OUT) do { unsigned a0 = cvtpk_a(P[B_+0], P[B_+1]), a1 = cvtpk_a(P[B_+2], P[B_+3]);                          \
        unsigned b0 = cvtpk_a(P[B_+4], P[B_+5]), b1 = cvtpk_a(P[B_+6], P[B_+7]);                                             \
        auto r0 = __builtin_amdgcn_permlane32_swap(a0, b0, false, false); auto r1 = __builtin_amdgcn_permlane32_swap(a1, b1, false, false); \
        u32x4 w = {r0[0], r1[0], r0[1], r1[1]}; OUT = *reinterpret_cast<bf16x8*>(&w); } while (0)
    PK4(p0, 0, pa0); PK4(p0, 8, pa1); PK4(p1, 0, pa2); PK4(p1, 8, pa3);
#undef PK4
}
template <int KB>
__device__ __forceinline__ void qkt(f32x16& p0, f32x16& p1, const char* lds, int r32, int hi, const bf16x8* qr) {
    p0 = f32x16{}; p1 = f32x16{};
    const char* kb[4]; const char* krb[4];
#pragma unroll
    for (int dd = 0; dd < 4; ++dd) { kb[dd] = lds + OFF_KN + KB * SHM_KN + KSWZ(r32, (dd * 16 + hi * 8) * 2); krb[dd] = lds + OFF_KR + KB * SHM_KR + KRSWZ(r32, dd * 2 + hi); }
#pragma unroll
    for (int d0 = 0; d0 < 8; ++d0) { const char* a = kb[d0 & 3] + (d0 >> 2) * 128;
        bf16x8 b0 = *reinterpret_cast<const bf16x8*>(a);
        bf16x8 b1 = *reinterpret_cast<const bf16x8*>(a + 32 * 256);
        p0 = __builtin_amdgcn_mfma_f32_32x32x16_bf16(b0, qr[d0], p0, 0, 0, 0);
        p1 = __builtin_amdgcn_mfma_f32_32x32x16_bf16(b1, qr[d0], p1, 0, 0, 0); }
#pragma unroll
    for (int dd = 0; dd < 4; ++dd) {
        bf16x8 b0 = *reinterpret_cast<const bf16x8*>(krb[dd]);
        bf16x8 b1 = *reinterpret_cast<const bf16x8*>(krb[dd] + 16 * 256);
        p0 = __builtin_amdgcn_mfma_f32_32x32x16_bf16(b0, qr[8 + dd], p0, 0, 0, 0);
        p1 = __builtin_amdgcn_mfma_f32_32x32x16_bf16(b1, qr[8 + dd], p1, 0, 0, 0); }
}
template <int VB>
__device__ __forceinline__ void pv_tile(f32x16* o, int vb0, bf16x8 pa0, bf16x8 pa1, bf16x8 pa2, bf16x8 pa3) {
#define TRRD(dst, off) asm volatile("ds_read_b64_tr_b16 %0, %1 offset:%2" : "=&v"(dst) : "v"(vb0), "i"(off) : "memory")
#define PV_D0(d0) do { s16x4 l0, l1, l2, l3, h0, h1, h2, h3; constexpr int b_ = OFF_V + VB * SHM_V + v_rd_off(d0, 0, 0);     \
        TRRD(l0, b_); TRRD(h0, b_ + 2048); TRRD(l1, b_ + 4096); TRRD(h1, b_ + 6144); TRRD(l2, b_ + 8192); TRRD(h2, b_ + 10240); TRRD(l3, b_ + 12288); TRRD(h3, b_ + 14336); \
        asm volatile("s_waitcnt lgkmcnt(0)" ::: "memory"); SBAR();   \
        o[d0] = __builtin_amdgcn_mfma_f32_32x32x16_bf16(pa0, (bf16x8){l0[0], l0[1], l0[2], l0[3], h0[0], h0[1], h0[2], h0[3]}, o[d0], 0, 0, 0);   \
        o[d0] = __builtin_amdgcn_mfma_f32_32x32x16_bf16(pa1, (bf16x8){l1[0], l1[1], l1[2], l1[3], h1[0], h1[1], h1[2], h1[3]}, o[d0], 0, 0, 0);   \
        o[d0] = __builtin_amdgcn_mfma_f32_32x32x16_bf16(pa2, (bf16x8){l2[0], l2[1], l2[2], l2[3], h2[0], h2[1], h2[2], h2[3]}, o[d0], 0, 0, 0);   \
        o[d0] = __builtin_amdgcn_mfma_f32_32x32x16_bf16(pa3, (bf16x8){l3[0], l3[1], l3[2], l3[3], h3[0], h3[1], h3[2], h3[3]}, o[d0], 0, 0, 0); } while (0)
    PV_D0(0); PV_D0(1); PV_D0(2); PV_D0(3);
#undef PV_D0
#undef TRRD
}
__device__ __forceinline__ void attn_block(int b, int h, int qb, const bf16_t* Q, const bf16_t* KN, const bf16_t* KR, const bf16_t* V, bf16_t* O, char* lds) {
    const int tid = threadIdx.x, wid = __builtin_amdgcn_readfirstlane(tid >> 6), lane = tid & 63, r32 = lane & 31, hi = lane >> 5;
    const size_t tok0 = (size_t)b * SEQ; const int q0 = qb * 256; const int NT = 4 * qb + 4;
    const int qlo = q0 + wid * 32, qm = qlo + r32 - 4 * hi;
    float* wsf = (float*)(lds + OFF_WS) + wid * 64; float* li_l = wsf, * al_l = wsf + 32;
    bf16x8 qr[12];
    { const bf16_t* qrow = Q + ((tok0 + qlo + r32) * NH + h) * QKD + hi * 8;
#pragma unroll
      for (int d0 = 0; d0 < 12; ++d0) qr[d0] = *reinterpret_cast<const bf16x8*>(qrow + d0 * 16); }
    const int sr = tid >> 4, sc = (tid & 15) * 8, rr = tid >> 3, rc = tid & 7;
    const int vst0 = v_st(sr, sc), vst1 = v_st(32 + sr, sc), kws = KSWZ(sr, sc * 2), krws = KRSWZ(rr, rc);
    const bf16_t* knp = KN + (tok0 + sr) * 1024 + h * 128 + sc; const bf16_t* vp = V + (tok0 + sr) * 1024 + h * 128 + sc;
    const bf16_t* krp = KR + ((tok0 + rr) * NH + h) * ROPE + rc * 8;
    const int vb0 = (int)(uintptr_t)lds + v_rd_base(lane);
    bf16x8 st_k0, st_k1, st_kr, st_v0, st_v1;
#define SLOAD(t) do { const size_t ko = (size_t)(t) * 64 * 1024; st_k0 = *reinterpret_cast<const bf16x8*>(knp + ko); st_k1 = *reinterpret_cast<const bf16x8*>(knp + ko + 32 * 1024); \
        st_v0 = *reinterpret_cast<const bf16x8*>(vp + ko); st_v1 = *reinterpret_cast<const bf16x8*>(vp + ko + 32 * 1024); st_kr = *reinterpret_cast<const bf16x8*>(krp + (size_t)(t) * 64 * NH * ROPE); } while (0)
#define SWRITE(bf) do { *(bf16x8*)(lds + OFF_KN + (bf) * SHM_KN + kws) = st_k0; *(bf16x8*)(lds + OFF_KN + (bf) * SHM_KN + kws + 32 * 256) = st_k1; \
        *(bf16x8*)(lds + OFF_KR + (bf) * SHM_KR + krws) = st_kr; *(bf16x8*)(lds + OFF_V + (bf) * SHM_V + vst0) = st_v0; *(bf16x8*)(lds + OFF_V + (bf) * SHM_V + vst1) = st_v1; } while (0)
#define VMW() asm volatile("s_waitcnt vmcnt(0)" ::: "memory")
    float m_reg = -1e30f, l_reg = 0.f; f32x16 o[4] = {};
    SLOAD(0); VMW(); SWRITE(0); __syncthreads();
    f32x16 p0, p1; bf16x8 pa0, pa1, pa2, pa3; float alpha;
#define RESC(a) do { if (__any((a) < 1.f)) { if (hi == 0) al_l[r32] = (a); asm volatile("s_waitcnt lgkmcnt(0)" ::: "memory");              \
                     _Pragma("unroll") for (int d_ = 0; d_ < 4; ++d_) _Pragma("unroll") for (int r = 0; r < 16; ++r) o[d_][r] *= al_l[crow(r, hi)]; } } while (0)
#define STEP(t, BUF) do { const bool more = (t) + 1 < NT;                                                 \
        if (more) { SLOAD((t) + 1); } SBAR();                                                               \
        qkt<BUF>(p0, p1, lds, r32, hi, qr);                                                                 \
        { const int kb_ = (t) * 64; if (kb_ + 63 > qlo) mask_tile(p0, p1, qm - kb_); }                       \
        partialSM(p0, p1, m_reg, alpha); RESC(alpha);                                                       \
        finishSM(p0, p1, alpha, l_reg, pa0, pa1, pa2, pa3); SBAR();                                         \
        pv_tile<BUF>(o, vb0, pa0, pa1, pa2, pa3);                                                           \
        if (more) { VMW(); SWRITE((BUF) ^ 1); }                                                             \
        __syncthreads(); } while (0)
    for (int t = 0; t < NT; t += 2) { STEP(t, 0); STEP(t + 1, 1); }
    if (hi == 0) li_l[r32] = l_reg; asm volatile("s_waitcnt lgkmcnt(0)" ::: "memory");
    float rli[16];
#pragma unroll
    for (int r = 0; r < 16; ++r) rli[r] = __builtin_amdgcn_rcpf(li_l[crow(r, hi)]);
    int hi_o = hi; asm volatile("" : "+v"(hi_o));
    bf16_t* Ow = O + (tok0 + qlo + 4 * hi_o) * 1024 + h * 128 + r32;
#pragma unroll
    for (int r = 0; r < 16; ++r) { const int orow = (r & 3) + 8 * (r >> 2);
#pragma unroll
        for (int d0 = 0; d0 < 4; ++d0) { const float v = o[d0][r] * rli[r]; const float vn = __shfl_xor(v, 1);
            if ((r32 & 1) == 0) *(unsigned*)(Ow + orow * 1024 + d0 * 32) = cvtpk(v, vn); } }
    __syncthreads();
#undef SLOAD
#undef SWRITE
#undef VMW
#undef RESC
#undef STEP
}
#undef KSWZ
#undef KRSWZ
#undef SBAR
}

__device__ __forceinline__ void tr_item(const float* src, size_t lsrc, bf16_t* dst, size_t ldd, LAS float* scr, int lane) {
#pragma unroll 8
    for (int i = 0; i < 32; ++i) { const int kk = 2 * i + (lane >> 5); scr[kk * 33 + (lane & 31)] = src[(size_t)kk * lsrc + (lane & 31)]; }
    LDS_WAIT(); asm volatile("" ::: "memory");
    const int c = lane & 7;
#pragma unroll
    for (int j = 0; j < 4; ++j) { const int n = (lane >> 3) + 8 * j; const LAS float* s = scr + (8 * c) * 33 + n;
        u32x4 o; o.x = cvtpk(s[0 * 33], s[1 * 33]); o.y = cvtpk(s[2 * 33], s[3 * 33]); o.z = cvtpk(s[4 * 33], s[5 * 33]); o.w = cvtpk(s[6 * 33], s[7 * 33]);
        *(u32x4*)(dst + (size_t)n * ldd + 8 * c) = o; }
    LDS_WAIT(); asm volatile("" ::: "memory");
}
__device__ __forceinline__ void rms_row_to_bf16(const float* xrow, const float* g, bf16_t* orow, int lane) {
    f32x4 v[4]; float s = 0.f;
#pragma unroll
    for (int j = 0; j < 4; ++j) { v[j] = *(const f32x4*)(xrow + 4 * lane + 256 * j); s += (v[j].x * v[j].x + v[j].y * v[j].y) + (v[j].z * v[j].z + v[j].w * v[j].w); }
    const float rs = 1.0f / sqrtf(wave_sum(s) * (1.0f / 1024.0f) + EPS);
#pragma unroll
    for (int j = 0; j < 4; ++j) { const f32x4 gg = *(const f32x4*)(g + 4 * lane + 256 * j); const f32x4 y = v[j] * rs * gg;
        *(u32x2*)(orow + 4 * lane + 256 * j) = (u32x2){cvtpk(y.x, y.y), cvtpk(y.z, y.w)}; }
}

__device__ __forceinline__ void p0_prologue(Frame& F, const Args& A) {
    LAS float* scr = (LAS float*)(F.lds + F.wave * 16384);
    unsigned char* ws = F.ws;
    bf16_t* WinT = (bf16_t*)(ws + WS_WIN); bf16_t* WuqT = (bf16_t*)(ws + WS_WUQ); bf16_t* Wgate = (bf16_t*)(ws + WS_WGATE);
    constexpr int I_IN = 16 * 146, I_SQ = 16 * 32, I_UQ = 4 * 48, I_UKV = 4 * 64, I_G = 64;
    constexpr int NITEMS = I_IN + 3 * I_SQ + I_UQ + I_UKV + 2 * I_G;
    for (int it = F.gw; it < NITEMS; it += F.NGW) {
        int r = it;
        if (r < I_IN) { const int kb = r / 146, nb = r % 146, n0 = 32 * nb, dr = n0 + (n0 >= 2624 ? 192 : 0);
            tr_item((const float*)A.in[3] + (size_t)(64 * kb) * 4672 + n0, 4672, WinT + (size_t)dr * 1024 + 64 * kb, 1024, scr, F.lane); continue; } r -= I_IN;
        if (r < 3 * I_SQ) { const int w = r / I_SQ, q = r % I_SQ, kb = q / 32, nb = q % 32; const float* src = (const float*)A.in[w == 0 ? 11 : (w == 1 ? 18 : 19)];
            bf16_t* dst = (bf16_t*)(ws + (w == 0 ? WS_WRNN : (w == 1 ? WS_WMLA : WS_WOUT)));
            tr_item(src + (size_t)(64 * kb) * 1024 + 32 * nb, 1024, dst + (size_t)(32 * nb) * 1024 + 64 * kb, 1024, scr, F.lane); continue; } r -= 3 * I_SQ;
        if (r < I_UQ) { const int kb = r / 48, nb = r % 48, n0 = 32 * nb, hh = n0 / 192, j0 = n0 % 192;
            tr_item((const float*)A.in[13] + (size_t)(64 * kb) * 1536 + n0, 1536, WuqT + (size_t)(hh * 256 + j0) * 256 + 64 * kb, 256, scr, F.lane); continue; } r -= I_UQ;
        if (r < I_UKV) { const int kb = r / 64, nb = r % 64;
            tr_item((const float*)A.in[15] + (size_t)(64 * kb) * 2048 + 32 * nb, 2048, (bf16_t*)(ws + WS_WUKV) + (size_t)(32 * nb) * 256 + 64 * kb, 256, scr, F.lane); continue; } r -= I_UKV;
        { const int which = r / I_G, q = r % I_G, blk = q / 8, kb = (q % 8) / 4, nb = q % 4;
          const float* src = (const float*)A.in[which == 0 ? 6 : 8] + (size_t)blk * 128 * 128 + (size_t)(64 * kb) * 128 + 32 * nb;
          tr_item(src, 128, Wgate + (size_t)(blk * 256 + which * 128 + 32 * nb) * 256 + (blk & 1) * 128 + 64 * kb, 256, scr, F.lane); }
    }
    const int gt = F.gw * 64 + F.lane, GT = F.NGW * 64; const u32x4 z4 = {0u, 0u, 0u, 0u};
    for (int i = gt; i < 192 * 128; i += GT) *(u32x4*)(WinT + (size_t)2624 * 1024 + (size_t)i * 8) = z4;
    for (int i = gt; i < 8 * 64 * 32; i += GT) { const int hh = i / (64 * 32), q = i % (64 * 32); *(u32x4*)(WuqT + (size_t)(hh * 256 + 192 + q / 32) * 256 + (q % 32) * 8) = z4; }
    for (int i = gt; i < 2048 * 16; i += GT) { const int row = i / 16, blk = row / 256; *(u32x4*)(Wgate + (size_t)row * 256 + ((blk & 1) ^ 1) * 128 + (i % 16) * 8) = z4; }
    float* c8 = (float*)(ws + WS_C8); float* Wr = (float*)(ws + WS_WR); float* br = (float*)(ws + WS_BR);
    for (int i = gt; i < 1024; i += GT) c8[i] = 8.0f * log1pf(expf(-((const float*)A.in[10])[i]));
    for (int i = gt; i < 1024 * 72; i += GT) { const int k = i / 72, c = i % 72; Wr[i] = c < 8 ? ((const float*)A.in[21])[k * 8 + c] : ((const float*)A.in[23])[k * 64 + c - 8]; }
    for (int i = gt; i < 72; i += GT) br[i] = i < 8 ? ((const float*)A.in[22])[i] : ((const float*)A.in[24])[i - 8];
    const float* x = (const float*)A.in[0]; bf16_t* U = (bf16_t*)(ws + WS_U);
    for (int m = F.gw; m < NTOK; m += F.NGW) rms_row_to_bf16(x + (size_t)m * DM, (const float*)A.in[2], U + (size_t)m * DM, F.lane);
}

__device__ __forceinline__ void p2_conv_norm(Frame& F, const Args& A) {
    unsigned char* ws = F.ws;
    const bf16_t* XR = (const bf16_t*)(ws + WS_XR); bf16_t* XC = (bf16_t*)(ws + WS_XC);
    const float* cw = (const float*)A.in[4]; const float* cb = (const float*)A.in[5];
    const int gt = F.gw * 64 + F.lane, GT = F.NGW * 64;
    for (int task = gt; task < (NTOK / 16) * 128; task += GT) {
        const int cgp = task & 127, run = task >> 7, t0 = run * 16, c0 = cgp * 8;
        float w[4][8], bsv[8];
#pragma unroll
        for (int k = 0; k < 4; ++k) { const f32x4 a = *(const f32x4*)(cw + k * 1024 + c0), b = *(const f32x4*)(cw + k * 1024 + c0 + 4);
            w[k][0] = a.x; w[k][1] = a.y; w[k][2] = a.z; w[k][3] = a.w; w[k][4] = b.x; w[k][5] = b.y; w[k][6] = b.z; w[k][7] = b.w; }
        { const f32x4 a = *(const f32x4*)(cb + c0), b = *(const f32x4*)(cb + c0 + 4); bsv[0] = a.x; bsv[1] = a.y; bsv[2] = a.z; bsv[3] = a.w; bsv[4] = b.x; bsv[5] = b.y; bsv[6] = b.z; bsv[7] = b.w; }
        f32x4 h0[3], h1[3];
        const bool has = (t0 % SEQ) != 0;
#pragma unroll
        for (int k = 0; k < 3; ++k) { if (has) unpack8(*(const u32x4*)(XR + (size_t)(t0 - 3 + k) * 1024 + c0), h0[k], h1[k]); else { h0[k] = (f32x4){0.f, 0.f, 0.f, 0.f}; h1[k] = h0[k]; } }
#pragma unroll 4
        for (int t = 0; t < 16; ++t) { f32x4 x0, x1; unpack8(*(const u32x4*)(XR + (size_t)(t0 + t) * 1024 + c0), x0, x1);
            f32x4 y0, y1;
#pragma unroll
            for (int j = 0; j < 4; ++j) { y0[j] = bsv[j] + w[0][j] * h0[0][j] + w[1][j] * h0[1][j] + w[2][j] * h0[2][j] + w[3][j] * x0[j];
                                          y1[j] = bsv[4 + j] + w[0][4 + j] * h1[0][j] + w[1][4 + j] * h1[1][j] + w[2][4 + j] * h1[2][j] + w[3][4 + j] * x1[j]; }
            *(u32x4*)(XC + (size_t)(t0 + t) * 1024 + c0) = pack8(y0, y1);
            h0[0] = h0[1]; h0[1] = h0[2]; h0[2] = x0; h1[0] = h1[1]; h1[1] = h1[2]; h1[2] = x1; }
    }
    for (int task = F.gw; task < 2 * NTOK; task += F.NGW) {
        const int which = task & 1, tok = task >> 1;
        const bf16_t* src = (const bf16_t*)(ws + (which ? WS_CKV : WS_CQ)) + (size_t)tok * 256 + 4 * F.lane; bf16_t* dst = (bf16_t*)(ws + (which ? WS_CKVN : WS_CQN)) + (size_t)tok * 256 + 4 * F.lane;
        const float* g = (const float*)A.in[which ? 14 : 12] + 4 * F.lane;
        const u32x2 w2 = *(const u32x2*)src; const float a = bflo(w2.x), b = bfhi(w2.x), c = bflo(w2.y), d = bfhi(w2.y);
        const float rs = 1.0f / sqrtf(wave_sum(a * a + b * b + c * c + d * d) * (1.0f / 256.0f) + EPS); const f32x4 gg = *(const f32x4*)g;
        *(u32x2*)dst = (u32x2){cvtpk(a * rs * gg.x, b * rs * gg.y), cvtpk(c * rs * gg.z, d * rs * gg.w)};
    }
}

template <bool FINAL>
__device__ __forceinline__ void p45_scan(Frame& F) {
    unsigned char* ws = F.ws;
    const unsigned* LOGA = (const unsigned*)(ws + WS_LOGA); unsigned* BIN = (unsigned*)(ws + WS_BIN); const unsigned* GY = (const unsigned*)(ws + WS_GY);
    f32x4* SUMM = (f32x4*)(ws + WS_SUMM);
    for (int u = F.vcu; u < NB * 64; u += F.G) {
        const int b = u >> 6, c = u & 63; const size_t base = ((size_t)b * SEQ + (size_t)c * 128) * 512 + F.tid;
        float h0 = 0.f, h1 = 0.f, sl0 = 0.f, sl1 = 0.f;
        if (FINAL) { for (int k = 0; k < c; ++k) { const f32x4 s = SUMM[((size_t)b * 64 + k) * 512 + F.tid]; h0 = __expf(s.x) * h0 + s.y; h1 = __expf(s.z) * h1 + s.w; } }
#pragma unroll 1
        for (int t0 = 0; t0 < 128; t0 += 8) { unsigned la[8], bb[8], gg[8], zz[8];
#pragma unroll
            for (int j = 0; j < 8; ++j) { const size_t o = base + (size_t)(t0 + j) * 512; la[j] = LOGA[o]; bb[j] = BIN[o]; gg[j] = FINAL ? GY[o] : 0u; }
#pragma unroll
            for (int j = 0; j < 8; ++j) { const float l0 = hlo(la[j]), l1 = hhi(la[j]); h0 = __expf(l0) * h0 + bflo(bb[j]); h1 = __expf(l1) * h1 + bfhi(bb[j]);
                if (FINAL) zz[j] = cvtpk(h0 * bflo(gg[j]), h1 * bfhi(gg[j])); else { sl0 += l0; sl1 += l1; zz[j] = 0u; } }
            if (FINAL) {
#pragma unroll
                for (int j = 0; j < 8; ++j) BIN[base + (size_t)(t0 + j) * 512] = zz[j]; } }
        if (!FINAL) SUMM[((size_t)b * 64 + c) * 512 + F.tid] = (f32x4){sl0, h0, sl1, h1};
    }
}

__device__ __forceinline__ void sincos_turns(float ang, float& s, float& c) {
    double rev = (double)ang * 0.15915494309189535; rev -= __builtin_floor(rev); const float fr = (float)rev;
    s = __builtin_amdgcn_sinf(fr); c = __builtin_amdgcn_cosf(fr);
}
__device__ __forceinline__ void p7_qknorm(Frame& F, const Args& A) {
    unsigned char* ws = F.ws; const int l = F.lane;
    bf16_t* Q = (bf16_t*)F.out; bf16_t* KN = (bf16_t*)(ws + WS_KN); bf16_t* KR = (bf16_t*)(ws + WS_KR); const bf16_t* KPE = (const bf16_t*)(ws + WS_KPE);
    const int* pos = (const int*)A.in[1]; const float* qg = (const float*)A.in[16]; const float* kg = (const float*)A.in[17];
    const int fi = 2 * (l & 15); const float if0 = A.invf[fi], if1 = A.invf[fi + 1];
    for (int task = F.gw; task < 2 * NTOK * NH; task += F.NGW) {
        const int isk = task >= NTOK * NH, id = isk ? task - NTOK * NH : task, tok = id >> 3, h = id & 7;
        unsigned* np = isk ? (unsigned*)(KN + (size_t)tok * 1024 + h * 128) + l : (unsigned*)(Q + ((size_t)tok * NH + h) * QKD) + l;
        unsigned* rp = isk ? (unsigned*)(KR + ((size_t)tok * NH + h) * ROPE) + (l & 31) : (unsigned*)(Q + ((size_t)tok * NH + h) * QKD + NOPE) + (l & 31);
        const unsigned* rsrc = isk ? (const unsigned*)(KPE + (size_t)tok * ROPE) + (l & 31) : rp;
        const float* g = isk ? kg : qg;
        const unsigned wn = *np; const unsigned wr_ = (l < 32) ? *rsrc : 0u;
        float n0 = bflo(wn), n1 = bfhi(wn), r0 = bflo(wr_), r1 = bfhi(wr_);
        const float ss = wave_sum(n0 * n0 + n1 * n1 + r0 * r0 + r1 * r1);
        const float rs = 1.0f / sqrtf(ss * (1.0f / 192.0f) + EPS); const float sc = isk ? 1.0f : QSCALE;
        const f32x2_t gn = *(const f32x2_t*)(g + 2 * l); const f32x2_t gr = *(const f32x2_t*)(g + NOPE + 2 * (l & 31));
        n0 *= rs * gn.x * sc; n1 *= rs * gn.y * sc; r0 *= rs * gr.x * sc; r1 *= rs * gr.y * sc;
        const float p = (float)pos[tok]; float s0, c0, s1, c1; sincos_turns(p * if0, s0, c0); sincos_turns(p * if1, s1, c1);
        const float o0 = __shfl_xor(r0, 16), o1 = __shfl_xor(r1, 16);
        float y0, y1; if ((l & 31) < 16) { y0 = r0 * c0 - o0 * s0; y1 = r1 * c1 - o1 * s1; } else { y0 = r0 * c0 + o0 * s0; y1 = r1 * c1 + o1 * s1; }
        *np = cvtpk(n0, n1); if (l < 32) *rp = cvtpk(y0, y1);
    }
}

__device__ __forceinline__ void p8_attention(Frame& F) {
    unsigned char* ws = F.ws;
    const bf16_t* Q = (const bf16_t*)F.out; const bf16_t* KN = (const bf16_t*)(ws + WS_KN); const bf16_t* KR = (const bf16_t*)(ws + WS_KR); const bf16_t* V = (const bf16_t*)(ws + WS_V); bf16_t* O = (bf16_t*)(ws + WS_O);
    for (int it = F.vcu; it < NB * NH * 16; it += F.G) { const int bh = it >> 4, x = it & 15;
        att::attn_block(bh >> 3, bh & 7, 31 - x, Q, KN, KR, V, O, (char*)F.lds);
        att::attn_block(bh >> 3, bh & 7, x, Q, KN, KR, V, O, (char*)F.lds); }
}

__device__ __forceinline__ void p12_router(Frame& F, const Args& A) {
    unsigned char* ws = F.ws;
    const float* H = F.out; bf16_t* U2 = (bf16_t*)(ws + WS_U2); const float* g2 = (const float*)A.in[20];
    const float* Wr = (const float*)(ws + WS_WR); const float* br = (const float*)(ws + WS_BR);
    unsigned* cnt = (unsigned*)(ws + WS_CTL); unsigned* rec = (unsigned*)(ws + WS_REC);
    LAS float* xf = (LAS float*)F.lds; LAS float* lg = (LAS float*)(F.lds + L_LG);
    for (int it = F.vcu; it < NTOK / 32; it += F.G) {
        const int T0 = it * 32;
#pragma unroll 1
        for (int j = 0; j < 4; ++j) { const int tl = F.wave * 4 + j; const float* row = H + (size_t)(T0 + tl) * DM;
            f32x4 v[4]; float s = 0.f;
#pragma unroll
            for (int q = 0; q < 4; ++q) { v[q] = *(const f32x4*)(row + 4 * F.lane + 256 * q); s += (v[q].x * v[q].x + v[q].y * v[q].y) + (v[q].z * v[q].z + v[q].w * v[q].w); }
            const float rs = 1.0f / sqrtf(wave_sum(s) * (1.0f / 1024.0f) + EPS);
#pragma unroll
            for (int q = 0; q < 4; ++q) { const f32x4 y = v[q] * rs * *(const f32x4*)(g2 + 4 * F.lane + 256 * q);
                *(LAS f32x4*)(xf + tl * 1024 + 4 * F.lane + 256 * q) = y;
                *(u32x2*)(U2 + (size_t)(T0 + tl) * DM + 4 * F.lane + 256 * q) = (u32x2){cvtpk(y.x, y.y), cvtpk(y.z, y.w)}; } }
        __syncthreads();
        if (F.tid < 504) { const int c = F.tid % 72, g = F.tid / 72; float acc[5] = {0.f, 0.f, 0.f, 0.f, 0.f};
#pragma unroll 2
            for (int k = 0; k < 1024; k += 4) { const float w0 = Wr[(k + 0) * 72 + c], w1 = Wr[(k + 1) * 72 + c], w2 = Wr[(k + 2) * 72 + c], w3 = Wr[(k + 3) * 72 + c];
#pragma unroll
                for (int j = 0; j < 5; ++j) { const int tk = g + 7 * j; if (tk < 32) { const f32x4 xv = *(const LAS f32x4*)(xf + tk * 1024 + k); acc[j] += (xv.x * w0 + xv.y * w1) + (xv.z * w2 + xv.w * w3); } } }
            const float bc = br[c];
#pragma unroll
            for (int j = 0; j < 5; ++j) { const int tk = g + 7 * j; if (tk < 32) lg[tk * 72 + c] = acc[j] + bc; } }
        __syncthreads();
        if (F.tid < 32) { const LAS float* l = lg + F.tid * 72; const int tok = T0 + F.tid;
            int gs = 0; float gm = l[0];
#pragma unroll
            for (int i = 1; i < 8; ++i) { const float v = l[i]; if (v > gm) { gm = v; gs = i; } }
            float gsum = 0.f;
#pragma unroll
            for (int i = 0; i < 8; ++i) gsum += expf(l[i] - gm);
            const float gp = 1.0f / gsum; const LAS float* e = l + 8 + gs * 8;
            int i0 = 0; float e0 = e[0];
#pragma unroll
            for (int i = 1; i < 8; ++i) { const float v = e[i]; if (v > e0) { e0 = v; i0 = i; } }
            int i1 = -1; float e1 = -__builtin_inff();
#pragma unroll
            for (int i = 0; i < 8; ++i) { const float v = e[i]; if (i != i0 && v > e1) { e1 = v; i1 = i; } }
            const float x1 = expf(e1 - e0), den = 1.0f / (1.0f + x1); const float gate0 = gp * den, gate1 = gp * x1 * den;
            const int ex0 = gs * 8 + i0, ex1 = gs * 8 + i1;
            const unsigned r0 = atomicAdd(cnt + ex0 * 16, 1u), r1 = atomicAdd(cnt + ex1 * 16, 1u);
            *(u32x4*)(rec + (size_t)tok * 8) = (u32x4){(unsigned)ex0, r0, __float_as_uint(gate0), (unsigned)ex1}; *(u32x2*)(rec + (size_t)tok * 8 + 4) = (u32x2){r1, __float_as_uint(gate1)}; }
        __syncthreads();
    }
    LAS float* scr = (LAS float*)(F.lds + F.wave * 16384);
    bf16_t* W13 = (bf16_t*)(ws + WS_W13); bf16_t* W2 = (bf16_t*)(ws + WS_W2);
    for (int it = F.gw; it < 3 * 8192; it += F.NGW) { const int which = it / 8192, q = it % 8192, e = q / 128, r = q % 128;
        if (which < 2) { const int kb = r / 8, nb = r % 8, n0 = 32 * nb, t = n0 / 128, jj = n0 % 128;
            tr_item((const float*)A.in[which == 0 ? 25 : 26] + (size_t)e * 1024 * 256 + (size_t)(64 * kb) * 256 + n0, 256, W13 + ((size_t)e * 512 + t * 256 + which * 128 + jj) * 1024 + 64 * kb, 1024, scr, F.lane); }
        else { const int kb = r / 32, nb = r % 32;
            tr_item((const float*)A.in[27] + (size_t)e * 256 * 1024 + (size_t)(64 * kb) * 1024 + 32 * nb, 1024, W2 + ((size_t)e * 1024 + 32 * nb) * 256 + 64 * kb, 256, scr, F.lane); } }
}
__device__ __forceinline__ void moe_tables(Frame& F) {
    LAS int* tile_e = (LAS int*)(F.lds + L_TILE_E); LAS int* pad_start = (LAS int*)(F.lds + L_PADSTART); LAS int* TT = (LAS int*)(F.lds + L_TT);
    if (F.wave == 0) { const unsigned* cnt = (const unsigned*)(F.ws + WS_CTL);
        const int c = (int)__hip_atomic_load(cnt + F.lane * 16, __ATOMIC_RELAXED, __HIP_MEMORY_SCOPE_AGENT); const int nt = (c + 255) >> 8; int incl = nt;
#pragma unroll
        for (int o = 1; o < 64; o <<= 1) { const int v = __shfl_up(incl, o); if (F.lane >= o) incl += v; }
        const int ts = incl - nt; pad_start[F.lane] = ts * 256;
        for (int r = 0; r < nt; ++r) tile_e[ts + r] = F.lane;
        if (F.lane == 63) TT[0] = incl; }
    __syncthreads();
}
__device__ __forceinline__ void p13_scatter(Frame& F) {
    unsigned char* ws = F.ws; moe_tables(F);
    const LAS int* pad_start = (const LAS int*)(F.lds + L_PADSTART);
    const unsigned* rec = (const unsigned*)(ws + WS_REC); const bf16_t* U2 = (const bf16_t*)(ws + WS_U2); bf16_t* XS = (bf16_t*)(ws + WS_XS);
    unsigned* tokpos = (unsigned*)(ws + WS_TOKPOS); float* gatepos = (float*)(ws + WS_GATEPOS);
    for (int tok = F.gw; tok < NTOK; tok += F.NGW) {
        const u32x4 ra = *(const u32x4*)(rec + (size_t)tok * 8); const u32x2 rb = *(const u32x2*)(rec + (size_t)tok * 8 + 4);
        const int p0 = pad_start[ra.x] + (int)ra.y, p1 = pad_start[ra.w] + (int)rb.x;
        const u32x4 a = *(const u32x4*)(U2 + (size_t)tok * DM + 8 * F.lane), b = *(const u32x4*)(U2 + (size_t)tok * DM + 512 + 8 * F.lane);
        *(u32x4*)(XS + (size_t)p0 * DM + 8 * F.lane) = a; *(u32x4*)(XS + (size_t)p0 * DM + 512 + 8 * F.lane) = b;
        *(u32x4*)(XS + (size_t)p1 * DM + 8 * F.lane) = a; *(u32x4*)(XS + (size_t)p1 * DM + 512 + 8 * F.lane) = b;
        if (F.lane == 0) { gatepos[p0] = __uint_as_float(ra.z); gatepos[p1] = __uint_as_float(rb.y); *(u32x2*)(tokpos + (size_t)tok * 2) = (u32x2){(unsigned)p0, (unsigned)p1}; }
    }
}
__device__ __forceinline__ void p16_combine(Frame& F) {
    unsigned char* ws = F.ws; const unsigned* tokpos = (const unsigned*)(ws + WS_TOKPOS); const bf16_t* YS = (const bf16_t*)(ws + WS_YS);
    for (int tok = F.gw; tok < NTOK; tok += F.NGW) { const u32x2 pp = *(const u32x2*)(tokpos + (size_t)tok * 2); float* orow = F.out + (size_t)tok * DM;
#pragma unroll
        for (int q = 0; q < 4; ++q) { const int c = 4 * F.lane + 256 * q; const u32x2 a = *(const u32x2*)(YS + (size_t)pp.x * DM + c), b = *(const u32x2*)(YS + (size_t)pp.y * DM + c);
            f32x4 h = *(const f32x4*)(orow + c); h.x += bflo(a.x) + bflo(b.x); h.y += bfhi(a.x) + bfhi(b.x); h.z += bflo(a.y) + bflo(b.y); h.w += bfhi(a.y) + bfhi(b.y); *(f32x4*)(orow + c) = h; } }
}

#ifndef MK_PER_PHASE
#define MK_PER_PHASE 0
#endif
constexpr int NPHASE = 17;
__global__ void __launch_bounds__(512, 2) hybrid_fwd(Args args) {
    extern __shared__ __attribute__((aligned(16))) unsigned char lds_raw[];
    cg::grid_group grid = cg::this_grid();
    Frame F;
    F.lds = (LAS unsigned char*)lds_raw; F.ws = args.ws; F.out = args.out;
    F.tid = threadIdx.x; F.lane = F.tid & 63; F.wave = __builtin_amdgcn_readfirstlane(F.tid >> 6);
    F.G = gridDim.x; { const int bx = blockIdx.x; F.vcu = (F.G % 8 == 0) ? (bx % 8) * (F.G / 8) + bx / 8 : bx; }
    F.gw = F.vcu * 8 + F.wave; F.NGW = F.G * 8;
    unsigned char* ws = args.ws;
    const int lo = args.ph_lo, hi = args.ph_hi;
#ifdef DBG_ONLY
#define IN(k) ((k) == DBG_ONLY && lo <= (k) && (k) < hi)
#else
#define IN(k) (lo <= (k) && (k) < hi)
#endif
#define SEAM(k) do { if (IN(k) && IN((k) + 1)) grid.sync(); } while (0)
    typedef pg8::GridOrder GO;
    const size_t T2K = 256 * 2048, T512 = 256 * 512;

    if (IN(0)) { p0_prologue(F, args); } SEAM(0);
    if (IN(1)) {
        pg8::Gemm g{(const char*)(ws + WS_U), (const char*)(ws + WS_WIN), 2048u, 2048u, 1024}; GO S; S.init(NTOK / 256, NP1 / 256, F.G, (int)blockIdx.x, T2K, 0, 0, T2K);
        pg8::EpiP1 E{(bf16_t*)(ws + WS_XR), (bf16_t*)(ws + WS_GY), (bf16_t*)(ws + WS_CQ), (bf16_t*)(ws + WS_CKV), (bf16_t*)(ws + WS_KPE), (bf16_t*)(ws + WS_SGA), (bf16_t*)(ws + WS_SGB)};
        pg8::gemm_phase<pg8::EpiP1, GO, true, true>(F.lds, g, S, E); } SEAM(1);
    if (IN(2)) { p2_conv_norm(F, args); } SEAM(2);
    if (IN(3)) {
        pg8::Gemm g{(const char*)(ws + WS_XC), (const char*)(ws + WS_WGATE), 2048u, 512u, 256}; GO S; S.init(NTOK / 256, 8, F.G, (int)blockIdx.x, T2K, 1, 512, T512);
        pg8::EpiGates E{(const bf16_t*)(ws + WS_XC), (const float*)args.in[7], (const float*)args.in[9], (const float*)(ws + WS_C8), (bf16_t*)(ws + WS_LOGA), (bf16_t*)(ws + WS_BIN)};
        pg8::gemm_phase<pg8::EpiGates, GO, true, true>(F.lds, g, S, E); } SEAM(3);
    if (IN(4)) { p45_scan<false>(F); } SEAM(4);
    if (IN(5)) { p45_scan<true>(F); } SEAM(5);
    if (IN(6)) {
        { pg8::Gemm g{(const char*)(ws + WS_CQN), (const char*)(ws + WS_WUQ), 512u, 512u, 256}; GO S; S.init(NTOK / 256, 8, F.G, (int)blockIdx.x, T512, 0, 0, T512);
          pg8::EpiQ E{(bf16_t*)F.out}; pg8::gemm_phase<pg8::EpiQ, GO, true, true>(F.lds, g, S, E); }
        { pg8::Gemm g{(const char*)(ws + WS_CKVN), (const char*)(ws + WS_WUKV), 512u, 512u, 256}; GO S; S.init(NTOK / 256, 8, F.G, (int)blockIdx.x, T512, 0, 0, T512);
          pg8::EpiKV E{(bf16_t*)(ws + WS_KN), (bf16_t*)(ws + WS_V)}; pg8::gemm_phase<pg8::EpiKV, GO, true, true>(F.lds, g, S, E); } } SEAM(6);
    if (IN(7)) { p7_qknorm(F, args); } SEAM(7);
    if (IN(8)) { p8_attention(F); } SEAM(8);
    if (IN(9)) {
        pg8::Gemm g{(const char*)(ws + WS_Z), (const char*)(ws + WS_WRNN), 2048u, 2048u, 1024}; GO S; S.init(NTOK / 256, 4, F.G, (int)blockIdx.x, T2K, 0, 0, T2K);
        pg8::EpiPlain E{(bf16_t*)(ws + WS_AOUT), 1024}; pg8::gemm_phase<pg8::EpiPlain, GO, true, true>(F.lds, g, S, E); } SEAM(9);
    if (IN(10)) {
        pg8::Gemm g{(const char*)(ws + WS_O), (const char*)(ws + WS_WMLA), 2048u, 2048u, 1024}; GO S; S.init(NTOK / 256, 4, F.G, (int)blockIdx.x, T2K, 0, 0, T2K);
        pg8::EpiMerge E{(const bf16_t*)(ws + WS_SGA), (const bf16_t*)(ws + WS_SGB), (const bf16_t*)(ws + WS_AOUT), (bf16_t*)(ws + WS_MERGED)}; pg8::gemm_phase<pg8::EpiMerge, GO, true, true>(F.lds, g, S, E); } SEAM(10);
    if (IN(11)) {
        pg8::Gemm g{(const char*)(ws + WS_MERGED), (const char*)(ws + WS_WOUT), 2048u, 2048u, 1024}; GO S; S.init(NTOK / 256, 4, F.G, (int)blockIdx.x, T2K, 0, 0, T2K);
        pg8::EpiResF32 E{(const float*)args.in[0], F.out}; pg8::gemm_phase<pg8::EpiResF32, GO, true, true>(F.lds, g, S, E); } SEAM(11);
    if (IN(12)) { p12_router(F, args); } SEAM(12);
    if (IN(13)) { p13_scatter(F); } SEAM(13);
    if (IN(14)) {
        moe_tables(F); const int TT = *(const LAS int*)(F.lds + L_TT);
        pg8::Gemm g{(const char*)(ws + WS_XS), (const char*)(ws + WS_W13), 2048u, 2048u, 1024};
        pg8::MoeOrder S{TT * 2, F.G, (int)blockIdx.x, 2, (const LAS int*)(F.lds + L_TILE_E), T2K, (size_t)512 * 2048, T2K};
        pg8::EpiUp E{(bf16_t*)(ws + WS_HS)}; pg8::gemm_phase<pg8::EpiUp, pg8::MoeOrder, true, true>(F.lds, g, S, E); } SEAM(14);
    if (IN(15)) {
        moe_tables(F); const int TT = *(const LAS int*)(F.lds + L_TT);
        pg8::Gemm g{(const char*)(ws + WS_HS), (const char*)(ws + WS_W2), 512u, 512u, 256};
        pg8::MoeOrder S{TT * 4, F.G, (int)blockIdx.x, 4, (const LAS int*)(F.lds + L_TILE_E), T512, (size_t)1024 * 512, T512};
        pg8::EpiDown E{(bf16_t*)(ws + WS_YS), (const float*)(ws + WS_GATEPOS)}; pg8::gemm_phase<pg8::EpiDown, pg8::MoeOrder, true, true>(F.lds, g, S, E); } SEAM(15);
    if (IN(16)) { p16_combine(F); }
#undef IN
#undef SEAM
}

extern "C" void kernel_launch(void* const* d_in, const int* in_sizes, int n_in, void* d_out, int out_size, void* d_ws, size_t ws_size, hipStream_t stream) {
    static int grid = 0;
    if (grid == 0) {
        if (n_in != 28 || in_sizes[0] != NTOK * DM || out_size != NTOK * DM || ws_size < WS_NEED) {
            fprintf(stderr, "kernel_launch: unexpected shapes (n_in %d, in0 %d, out %d, ws %zu); nothing launched\n", n_in, n_in > 0 ? in_sizes[0] : -1, out_size, ws_size); grid = -1; return; }
        int dev = 0, cus = 0, per_cu = 0;
        (void)hipGetDevice(&dev); (void)hipDeviceGetAttribute(&cus, hipDeviceAttributeMultiprocessorCount, dev);
        (void)hipFuncSetAttribute((const void*)hybrid_fwd, hipFuncAttributeMaxDynamicSharedMemorySize, LDS_BYTES);
        (void)hipOccupancyMaxActiveBlocksPerMultiprocessor(&per_cu, (const void*)hybrid_fwd, 512, LDS_BYTES);
        if (per_cu < 1) { fprintf(stderr, "kernel_launch: occupancy query reports %d workgroups per CU\n", per_cu); }
        (void)hipGetLastError();
        grid = cus > 0 ? cus : 256;
    }
    if (grid < 0) return;
    (void)hipMemsetAsync((char*)d_ws + WS_CTL, 0, CTL_ZERO_BYTES, stream);
    Args a{};
    for (int i = 0; i < 28; ++i) a.in[i] = d_in[i];
    a.out = (float*)d_out; a.ws = (unsigned char*)d_ws;
    for (int i = 0; i < 32; ++i) a.invf[i] = (float)pow(10000.0, -(double)(2 * i) / 64.0);
#if MK_PER_PHASE
    for (int p = 0; p < NPHASE; ++p) { a.ph_lo = p; a.ph_hi = p + 1; void* kargs[] = {&a};
        hipError_t e = hipLaunchCooperativeKernel((const void*)hybrid_fwd, dim3(grid), dim3(512), kargs, LDS_BYTES, stream);
        if (e != hipSuccess) { fprintf(stderr, "kernel_launch: launch of phase %d failed: %s\n", p, hipGetErrorString(e)); break; } }
#else
    a.ph_lo = 0; a.ph_hi = NPHASE; void* kargs[] = {&a};
    hipError_t e = hipLaunchCooperativeKernel((const void*)hybrid_fwd, dim3(grid), dim3(512), kargs, LDS_BYTES, stream);
    if (e != hipSuccess) fprintf(stderr, "kernel_launch: cooperative launch failed: %s (grid %d)\n", hipGetErrorString(e), grid);
#endif
}
```

```cpp
#include <hip/hip_runtime.h>
#include <hip/hip_cooperative_groups.h>
#include <cstdio>
#include <cstdint>
#include <cmath>
namespace cg = cooperative_groups;

constexpr int NB = 4, SEQ = 8192, DM = 1024, NTOK = NB * SEQ;
constexpr int NH = 8, QKD = 192, NOPE = 128, ROPE = 64, VD = 128;
constexpr int NE = 64, DE = 256;
constexpr int NP1 = 4864;
constexpr int MPAD = 81920;
constexpr float EPS = 1e-6f;
constexpr float QSCALE = 0.07216878364870322f * 1.4426950408889634f;

#define GAS __attribute__((address_space(1)))
#define LAS __attribute__((address_space(3)))
typedef unsigned short bf16_t;
typedef short bf16x8 __attribute__((ext_vector_type(8)));
typedef short s16x4 __attribute__((ext_vector_type(4)));
typedef float f32x4 __attribute__((ext_vector_type(4)));
typedef float f32x16 __attribute__((ext_vector_type(16)));
typedef unsigned u32x4 __attribute__((ext_vector_type(4)));
typedef unsigned u32x2 __attribute__((ext_vector_type(2)));
typedef float f32x2_t __attribute__((ext_vector_type(2)));
typedef __bf16 bf16x2_t __attribute__((ext_vector_type(2)));
typedef _Float16 f16x2_t __attribute__((ext_vector_type(2)));

__device__ __forceinline__ unsigned cvtpk(float lo, float hi) { f32x2_t v = {lo, hi}; bf16x2_t b = __builtin_convertvector(v, bf16x2_t); return __builtin_bit_cast(unsigned, b); }
__device__ __forceinline__ unsigned cvtpk_h(float lo, float hi) { f16x2_t v = {(_Float16)lo, (_Float16)hi}; return __builtin_bit_cast(unsigned, v); }
__device__ __forceinline__ float bflo(unsigned w) { return __uint_as_float(w << 16); }
__device__ __forceinline__ float bfhi(unsigned w) { return __uint_as_float(w & 0xffff0000u); }
__device__ __forceinline__ float hlo(unsigned w) { f16x2_t v = __builtin_bit_cast(f16x2_t, w); return (float)v[0]; }
__device__ __forceinline__ float hhi(unsigned w) { f16x2_t v = __builtin_bit_cast(f16x2_t, w); return (float)v[1]; }
__device__ __forceinline__ u32x4 pack8(f32x4 a, f32x4 b) { return (u32x4){cvtpk(a[0], a[1]), cvtpk(a[2], a[3]), cvtpk(b[0], b[1]), cvtpk(b[2], b[3])}; }
__device__ __forceinline__ void unpack8(u32x4 w, f32x4& a, f32x4& b) { a = (f32x4){bflo(w.x), bfhi(w.x), bflo(w.y), bfhi(w.y)}; b = (f32x4){bflo(w.z), bfhi(w.z), bflo(w.w), bfhi(w.w)}; }
__device__ __forceinline__ float sigmoidf_(float x) { return __builtin_amdgcn_rcpf(1.0f + __builtin_amdgcn_exp2f(-1.4426950408889634f * x)); }
__device__ __forceinline__ float gelu_tanh(float x) { const float u = 1.5957691216057308f * (x + 0.044715f * x * x * x); return x * __builtin_amdgcn_rcpf(1.0f + __builtin_amdgcn_exp2f(-1.4426950408889634f * u)); }
__device__ __forceinline__ float wave_sum(float v) {
#pragma unroll
    for (int o = 1; o < 64; o <<= 1) v += __shfl_xor(v, o);
    return v;
}
#define LDS_WAIT() asm volatile("s_waitcnt lgkmcnt(0)" ::: "memory")
__device__ __forceinline__ int lane_id_v() { int l; asm volatile("v_mbcnt_lo_u32_b32 %0, -1, 0\n\tv_mbcnt_hi_u32_b32 %0, -1, %0" : "=v"(l)); return l; }

constexpr size_t MiB = 1u << 20;
constexpr size_t WS_CTL = 0, WS_BAR = 16384, CTL_ZERO_BYTES = 32768;
constexpr size_t WS_C8 = 512 * 1024, WS_WR = WS_C8 + 4096, WS_BR = WS_WR + 1024 * 96 * 4;
constexpr size_t WS_WIN = 1 * MiB, WS_WRNN = WS_WIN + (size_t)NP1 * 1024 * 2, WS_WMLA = WS_WRNN + 2 * MiB, WS_WOUT = WS_WMLA + 2 * MiB,
                 WS_WUQ = WS_WOUT + 2 * MiB, WS_WUKV = WS_WUQ + 1 * MiB, WS_WGATE = WS_WUKV + 1 * MiB, WS_WEND = WS_WGATE + 1 * MiB;
constexpr size_t S0 = 20 * MiB, S1 = 84 * MiB, S2 = 148 * MiB, S3 = 212 * MiB, S4 = 276 * MiB, S5 = 340 * MiB, S6 = 404 * MiB, ST = 468 * MiB;
static_assert(WS_WEND <= S0, "weights fit below the slots");
constexpr size_t WS_U = S0, WS_XR = S1, WS_GY = S2, WS_SGA = S3, WS_SGB = S4, WS_XC = S5, WS_CQN = S6, WS_CKVN = S6 + 16 * MiB;
constexpr size_t WS_CQ = ST, WS_CKV = ST + 16 * MiB, WS_KPE = ST + 32 * MiB, WS_SUMM = ST + 36 * MiB, WS_REC = ST + 38 * MiB, WS_TOKPOS = ST + 39 * MiB, WS_GATEPOS = WS_TOKPOS + 512 * 1024;
constexpr size_t WS_KPESS = ST + 41 * MiB, WS_RSK = ST + 42 * MiB;
constexpr size_t OUT_CS = 96 * MiB;
constexpr size_t WS_LOGA = S0, WS_BIN = S5, WS_Z = S1;
constexpr size_t WS_KN = S2, WS_V = S0, WS_KR = S5, WS_O = S6;
constexpr size_t WS_AOUT = S5, WS_MERGED = S0;
constexpr size_t WS_U2 = S1, WS_W13 = S2, WS_W2 = S3, WS_LIST = 60 * MiB, WS_GLIST = 68 * MiB, WS_YS = 244 * MiB, WS_HS = S0, WS_MIX = S6;
constexpr size_t WS_RSL = 76 * MiB;
constexpr size_t WS_LG = S5, WS_RSTOK = S5 + 16 * MiB;
constexpr size_t WS_NEED = 512 * MiB;
static_assert(WS_GATEPOS + (size_t)MPAD * 4 <= WS_NEED && WS_YS + (size_t)MPAD * 2048 <= WS_MIX && WS_HS + (size_t)MPAD * 512 <= WS_LIST && WS_GLIST + 8 * MiB <= WS_RSL && WS_RSL + 8 * MiB <= S1 && WS_W2 + 32 * MiB <= WS_YS, "workspace map");

constexpr int RING_BYTES = 131072;
constexpr int L_TILE_E = RING_BYTES, L_PADSTART = L_TILE_E + 1536, L_TILE_S = L_PADSTART + 256, L_CNT = L_TILE_S + 256, L_TT = RING_BYTES + 2304, L_LG = RING_BYTES + 4096;
constexpr int L_KVX = RING_BYTES + 4096, L_KVC = RING_BYTES + 8192;
constexpr int L_BARST = RING_BYTES + 2320;
constexpr int L_STAMP = RING_BYTES + 2560;
constexpr int LDS_BYTES = 147456;
static_assert(L_LG + 32 * 72 * 4 <= LDS_BYTES, "LDS map");

#ifdef PROBE
#define STAMPX(F, k) do { if (blockIdx.x == 0 && (F).tid == 0) ((LAS unsigned long long*)((F).lds + L_STAMP))[k] = __builtin_amdgcn_s_memrealtime(); } while (0)
#else
#define STAMPX(F, k) do {} while (0)
#endif
struct Args { const void* in[28]; float* out; unsigned char* ws; float invf[32]; int ph_lo, ph_hi; };

struct Frame {
    LAS unsigned char* lds; unsigned char* ws; float* out;
    int tid, lane, wave, vcu, G, gw, NGW;
};
namespace pg8 {
#define PG8_LAS __attribute__((address_space(3)))
typedef unsigned short bf16_t;
typedef short bf16x8 __attribute__((ext_vector_type(8)));
typedef float f32x4 __attribute__((ext_vector_type(4)));
typedef unsigned u32x4 __attribute__((ext_vector_type(4)));
constexpr int BM = 256, BK = 64, HALF = 128, HTB = HALF * BK * 2  , STAGE_BYTES = 8 * HTB, NXCD = 8, WGM = 8;

__host__ __device__ __forceinline__ int lds_byte(int r, int c) { const int st = (r >> 4) * 2 + (c >> 5), rr = r & 15, cc = c & 31, ob = rr * 64 + cc * 2; return st * 1024 + (ob ^ (((ob >> 9) & 1) << 5)); }
__host__ __device__ __forceinline__ void stage_rc(int b, int& R, int& C) { const int st = b / 1024, sb = b % 1024, swz = sb ^ (((sb >> 9) & 1) << 5); R = (st >> 1) * 16 + swz / 64; C = (st & 1) * 32 + (swz % 64) / 2; }
__host__ __device__ __forceinline__ int perm32(int rho) { const int n = rho >> 4, i = rho & 15; return 8 * (i >> 2) + 4 * n + (i & 3); }

struct Unit { int pm, pn, ex; };
struct Gemm { const char* A; const char* B; unsigned lda, ldb; int K; const char* A2; int ksw; };
__device__ __forceinline__ unsigned cvt_pk_bf16(float lo, float hi) { unsigned r; asm volatile("v_cvt_pk_bf16_f32 %0, %1, %2" : "=v"(r) : "v"(lo), "v"(hi)); return r; }
template <class Epi, class Sched, bool ALIGN_EPI = false, bool SP2 = false>
__device__ __forceinline__ void gemm_phase(PG8_LAS unsigned char* lds, const Gemm g, const Sched& S, const Epi& E, int wid_in) {
    const int wid = wid_in, lane = lane_id_v(), tid = wid * 64 + lane, wr = wid >> 2, wc = wid & 3, fr = lane & 15, fq = lane >> 4;
    const int K = g.K, nt = K / BK;
    unsigned voffA[2], voffB[2]; int rowA[2]; unsigned colA[2];
#pragma unroll
    for (int i = 0; i < 2; ++i) { int R, C; stage_rc(tid * 16 + i * 8192, R, C); const int Rb = Epi::PERM ? ((R & ~31) + perm32(R & 31)) : R; rowA[i] = R; colA[i] = (unsigned)C * 2u;
        voffA[i] = (unsigned)R * g.lda + (unsigned)C * 2u; voffB[i] = (unsigned)Rb * g.ldb + (unsigned)C * 2u; }
    unsigned cvA[2][2], nvA[2][2];
    const size_t kstep = (size_t)(BK * 2);
    const size_t hstepA = (size_t)HALF * g.lda, hstepB = (size_t)HALF * g.ldb;
    const unsigned ldsw = (unsigned)wid * 1024u;
    const int aoff = lds_byte(wr * 64 + fr, fq * 8), boff = lds_byte(wc * 32 + fr, fq * 8);
#define PG8_SA(b, h) (((b) * 2 + (h)) * HTB)
#define PG8_SB(b, h) ((4 + (b) * 2 + (h)) * HTB)
#define PG8_STAGE(bufoff, gbase, voff) do { _Pragma("unroll") for (int _i = 0; _i < 2; ++_i) \
        __builtin_amdgcn_global_load_lds((const unsigned*)((const char*)(gbase) + (voff)[_i]), (PG8_LAS unsigned*)(lds + (bufoff) + ldsw + _i * 8192), 16, 0, 0); } while (0)
#define PG8_STAGE_A(bufoff, gbase, half, isn) do { if constexpr (Sched::GATHER) { unsigned v_[2] = {(isn) ? nvA[half][0] : cvA[half][0], (isn) ? nvA[half][1] : cvA[half][1]}; PG8_STAGE(bufoff, gbase, v_); } \
        else { PG8_STAGE(bufoff, (gbase) + (half) * hstepA, voffA); } } while (0)
#define PG8_LDA(dst, b, h) do { _Pragma("unroll") for (int m = 0; m < 4; ++m) _Pragma("unroll") for (int k = 0; k < 2; ++k) dst[m][k] = *(const PG8_LAS bf16x8*)(lds + PG8_SA(b, h) + aoff + m * 2048 + k * 1024); } while (0)
#define PG8_LDB(dst, b, h) do { _Pragma("unroll") for (int n = 0; n < 2; ++n) _Pragma("unroll") for (int k = 0; k < 2; ++k) dst[n][k] = *(const PG8_LAS bf16x8*)(lds + PG8_SB(b, h) + boff + n * 2048 + k * 1024); } while (0)
#define PG8_MMA(ai, bj, At, Bt) do { __builtin_amdgcn_s_setprio(1); _Pragma("unroll") for (int m = 0; m < 4; ++m) _Pragma("unroll") for (int n = 0; n < 2; ++n) _Pragma("unroll") for (int k = 0; k < 2; ++k) \
        acc[ai][bj][m][n] = __builtin_amdgcn_mfma_f32_16x16x32_bf16(Bt[n][k], At[m][k], acc[ai][bj][m][n], 0, 0, 0); __builtin_amdgcn_s_setprio(0); } while (0)
#define PG8_WAIT_V(n) asm volatile("s_waitcnt vmcnt(" #n ")" ::: "memory")
#define PG8_WAIT_L(n) asm volatile("s_waitcnt lgkmcnt(" #n ")" ::: "memory")
#define PG8_BAR __builtin_amdgcn_s_barrier()
#define PG8_SCHED __builtin_amdgcn_sched_barrier(0)
    Unit cur, nxt; int ui = 0;
    if (!S.next(0, cur)) return;
    f32x4 acc[2][2][4][2];
#pragma unroll
    for (int a = 0; a < 2; ++a)
#pragma unroll
        for (int b = 0; b < 2; ++b)
#pragma unroll
            for (int m = 0; m < 4; ++m)
#pragma unroll
                for (int n = 0; n < 2; ++n) acc[a][b][m][n] = (f32x4){0.f, 0.f, 0.f, 0.f};
    bf16x8 At[4][2], B0[2][2], B1[2][2];
    const char* cA = g.A + S.aoff(cur); const char* cB = g.B + S.boff(cur); const char* cA2 = g.A2 + S.aoff(cur);
    if constexpr (Sched::GATHER) { S.gather(cur, rowA, colA, g.lda, cvA);
#pragma unroll
        for (int h_ = 0; h_ < 2; ++h_) { nvA[h_][0] = cvA[h_][0]; nvA[h_][1] = cvA[h_][1]; } }
    S.a_ready(cur);
    if constexpr (SP2) {
        PG8_STAGE(PG8_SB(0, 0), cB, voffB); PG8_STAGE(PG8_SB(0, 1), cB + hstepB, voffB); PG8_STAGE_A(PG8_SA(0, 0), cA, 0, false); PG8_STAGE_A(PG8_SA(0, 1), cA, 1, false);
        if (wr == 1) PG8_BAR;
        PG8_WAIT_V(2); PG8_BAR;
        PG8_STAGE(PG8_SB(1, 0), cB + kstep, voffB); PG8_STAGE_A(PG8_SA(1, 0), cA + kstep, 0, false); PG8_STAGE(PG8_SB(1, 1), cB + hstepB + kstep, voffB);
        PG8_WAIT_V(6); PG8_BAR;
    } else {
        PG8_STAGE(PG8_SB(0, 0), cB, voffB); PG8_STAGE_A(PG8_SA(0, 0), cA, 0, false); PG8_STAGE(PG8_SB(0, 1), cB + hstepB, voffB); PG8_STAGE_A(PG8_SA(0, 1), cA, 1, false);
        if (wr == 1) PG8_BAR;
        PG8_WAIT_V(4); PG8_BAR;
        PG8_STAGE(PG8_SB(1, 0), cB + kstep, voffB); PG8_STAGE_A(PG8_SA(1, 0), cA + kstep, 0, false); PG8_STAGE(PG8_SB(1, 1), cB + hstepB + kstep, voffB);
        PG8_WAIT_V(6); PG8_BAR;
    }
    for (;;) {
        const bool has_next = S.next(ui + 1, nxt);
        if constexpr (Sched::GATHER) { if (has_next) S.gather(nxt, rowA, colA, g.lda, nvA); }
        const char* nA = has_next ? g.A + S.aoff(nxt) : cA; const char* nB = has_next ? g.B + S.boff(nxt) : cB;
#pragma unroll 1
        for (int t = 0; t < nt; t += 2) {
            const bool last = (t == nt - 2);
            if constexpr (Epi::HAS_MID) { if (t == g.ksw) E.mid(acc, cur, wr, wc, fr, fq); }
            const char* a1 = (t + 1 < g.ksw) ? cA + (size_t)(t + 1) * kstep : cA2 + (size_t)(t + 1 - g.ksw) * kstep;
            const char* a2 = last ? nA : ((t + 2 < g.ksw) ? cA + (size_t)(t + 2) * kstep : cA2 + (size_t)(t + 2 - g.ksw) * kstep); const char* b2 = last ? nB : cB + (size_t)(t + 2) * kstep;
            const char* a3 = a2 + kstep; const char* b3 = b2 + kstep;
            if (last && has_next) S.a_ready(nxt);
            if constexpr (SP2) {
            PG8_LDB(B0, 0, 0); PG8_LDB(B1, 0, 1); PG8_SCHED; PG8_LDA(At, 0, 0); PG8_STAGE_A(PG8_SA(1, 1), a1, 1, false);
            PG8_WAIT_V(8); PG8_WAIT_L(0); PG8_BAR; PG8_MMA(0, 0, At, B0); PG8_MMA(0, 1, At, B1); PG8_BAR; PG8_SCHED;
            PG8_LDA(At, 0, 1); PG8_STAGE(PG8_SB(0, 0), b2, voffB); PG8_STAGE(PG8_SB(0, 1), b2 + hstepB, voffB); PG8_STAGE_A(PG8_SA(0, 0), a2, 0, last);
            PG8_WAIT_V(8); PG8_WAIT_L(0); PG8_BAR; PG8_MMA(1, 0, At, B0); PG8_MMA(1, 1, At, B1); PG8_BAR; PG8_SCHED;
            PG8_LDB(B0, 1, 0); PG8_LDB(B1, 1, 1); PG8_SCHED; PG8_LDA(At, 1, 0); PG8_STAGE_A(PG8_SA(0, 1), a2, 1, last);
            PG8_WAIT_V(8); PG8_WAIT_L(0); PG8_BAR; PG8_MMA(0, 0, At, B0); PG8_MMA(0, 1, At, B1); PG8_BAR; PG8_SCHED;
            PG8_LDA(At, 1, 1); PG8_STAGE(PG8_SB(1, 0), b3, voffB); PG8_STAGE(PG8_SB(1, 1), b3 + hstepB, voffB); PG8_STAGE_A(PG8_SA(1, 0), a3, 0, last);
            PG8_WAIT_V(8); PG8_WAIT_L(0); PG8_BAR; PG8_MMA(1, 0, At, B0); PG8_MMA(1, 1, At, B1); PG8_BAR; PG8_SCHED;
            } else {
            PG8_LDB(B0, 0, 0); PG8_SCHED; PG8_LDA(At, 0, 0); PG8_STAGE_A(PG8_SA(1, 1), a1, 1, false);
            PG8_WAIT_L(8); PG8_BAR; PG8_WAIT_L(0); PG8_MMA(0, 0, At, B0); PG8_BAR; PG8_SCHED;
            PG8_LDB(B1, 0, 1); PG8_STAGE(PG8_SB(0, 0), b2, voffB);
            PG8_BAR; PG8_WAIT_L(0); PG8_MMA(0, 1, At, B1); PG8_BAR;
            PG8_LDA(At, 0, 1); PG8_STAGE_A(PG8_SA(0, 0), a2, 0, last);
            PG8_BAR; PG8_WAIT_L(0); PG8_MMA(1, 0, At, B0); PG8_BAR; PG8_SCHED;
            PG8_STAGE(PG8_SB(0, 1), b2 + hstepB, voffB);
            PG8_WAIT_V(6); PG8_BAR; PG8_MMA(1, 1, At, B1); PG8_BAR;
            PG8_LDB(B0, 1, 0); PG8_SCHED; PG8_LDA(At, 1, 0); PG8_STAGE_A(PG8_SA(0, 1), a2, 1, last);
            PG8_WAIT_L(8); PG8_BAR; PG8_WAIT_L(0); PG8_MMA(0, 0, At, B0); PG8_BAR; PG8_SCHED;
            PG8_LDB(B1, 1, 1); PG8_STAGE(PG8_SB(1, 0), b3, voffB);
            PG8_BAR; PG8_WAIT_L(0); PG8_MMA(0, 1, At, B1); PG8_BAR;
            PG8_LDA(At, 1, 1); PG8_STAGE_A(PG8_SA(1, 0), a3, 0, last);
            PG8_BAR; PG8_WAIT_L(0); PG8_MMA(1, 0, At, B0); PG8_BAR; PG8_SCHED;
            PG8_STAGE(PG8_SB(1, 1), b3 + hstepB, voffB);
            PG8_WAIT_V(6); PG8_BAR; PG8_MMA(1, 1, At, B1); PG8_BAR;
            }
        }
        if constexpr (ALIGN_EPI) { if (wr == 0) PG8_BAR; }
        if constexpr (!Epi::AFTER_DRAIN) { E(acc, cur, wr, wc, fr, fq); S.done(cur); }
        if (!has_next) break;
#pragma unroll
        for (int a = 0; a < 2; ++a)
#pragma unroll
            for (int b = 0; b < 2; ++b)
#pragma unroll
                for (int m = 0; m < 4; ++m)
#pragma unroll
                    for (int n = 0; n < 2; ++n) acc[a][b][m][n] = (f32x4){0.f, 0.f, 0.f, 0.f};
        cur = nxt; cA = nA; cB = nB; cA2 = g.A2 + S.aoff(cur); ++ui;
        if constexpr (Sched::GATHER) {
#pragma unroll
            for (int h_ = 0; h_ < 2; ++h_) { cvA[h_][0] = nvA[h_][0]; cvA[h_][1] = nvA[h_][1]; } }
        if constexpr (ALIGN_EPI) { if (wr == 1) PG8_BAR; }
    }
    PG8_WAIT_V(0);
    if constexpr (!ALIGN_EPI) { if (wr == 0) PG8_BAR; }
    PG8_BAR;
    if constexpr (Epi::AFTER_DRAIN) { E.fused(acc, cur, wr, wc, fr, fq, lds, wid, lane); S.done(cur); }
#undef PG8_SA
#undef PG8_SB
#undef PG8_STAGE
#undef PG8_STAGE_A
#undef PG8_LDA
#undef PG8_LDB
#undef PG8_MMA
#undef PG8_WAIT_V
#undef PG8_WAIT_L
#undef PG8_BAR
#undef PG8_SCHED
}
}

namespace pg8 {
struct GridOrder {
    static constexpr bool GATHER = false;
    int nM, nN, nwg, G, c, a_sh; size_t a_sm, a_sn, b_sn;
    __device__ __forceinline__ void init(int nM_, int nN_, int G_, int c_, size_t a_sm_, int a_sh_, size_t a_sn_, size_t b_sn_) { nM = nM_; nN = nN_; nwg = nM * nN; G = G_; c = c_; a_sm = a_sm_; a_sh = a_sh_; a_sn = a_sn_; b_sn = b_sn_; }
    __device__ __forceinline__ bool next(int i, Unit& u) const {
        const long L = (long)i * G + c; if (L >= nwg) return false;
        int wgid = (int)L; { const int q = nwg / NXCD, r = nwg % NXCD, xcd = wgid % NXCD, off = wgid / NXCD; wgid = (xcd < r ? xcd * (q + 1) : r * (q + 1) + (xcd - r) * q) + off; }
        const int nig = WGM * nN, gid = wgid / nig, fm = gid * WGM, gsz = (nM - fm) < WGM ? (nM - fm) : WGM;
        u.pm = fm + ((wgid % nig) % gsz); u.pn = (wgid % nig) / gsz; u.ex = 0; return true;
    }
    __device__ __forceinline__ size_t aoff(const Unit& u) const { return (size_t)u.pm * a_sm + (size_t)(u.pn >> a_sh) * a_sn; }
    __device__ __forceinline__ size_t boff(const Unit& u) const { return (size_t)u.pn * b_sn; }
    __device__ __forceinline__ void a_ready(const Unit&) const {}
    __device__ __forceinline__ void done(const Unit&) const {}
};
template <bool GATHER_>
struct MoeOrderT {
    static constexpr bool GATHER = GATHER_;
    int total, G, c, nsub; const PG8_LAS int* tile_e; const PG8_LAS int* tile_s; const PG8_LAS int* cnt_e; const unsigned* list; size_t a_sm, b_se, b_sn;
    __device__ __forceinline__ bool next(int i, Unit& u) const {
        const long L = (long)i * G + c; if (L >= total) return false;
        const int rt = (int)L / nsub, e = __builtin_amdgcn_readfirstlane(tile_e[rt]), ts = __builtin_amdgcn_readfirstlane(tile_s[e]);
        u.pm = rt; u.pn = (int)L - rt * nsub; u.ex = e | ((rt - ts) << 8); return true;
    }
    __device__ __forceinline__ size_t aoff(const Unit& u) const { return GATHER_ ? (size_t)0 : (size_t)u.pm * a_sm; }
    __device__ __forceinline__ size_t boff(const Unit& u) const { return (size_t)(u.ex & 255) * b_se + (size_t)u.pn * b_sn; }
    __device__ __forceinline__ void gather(const Unit& u, const int (&rowA)[2], const unsigned (&colA)[2], unsigned lda, unsigned (&v)[2][2]) const {
        const int e = u.ex & 255, base = (u.ex >> 8) * 256, n = __builtin_amdgcn_readfirstlane(cnt_e[e]);
#pragma unroll
        for (int h = 0; h < 2; ++h)
#pragma unroll
            for (int i = 0; i < 2; ++i) { const int lr = base + h * 128 + rowA[i]; const unsigned tok = (lr < n) ? list[(size_t)e * 32768 + lr] : 0u; v[h][i] = tok * lda + colA[i]; }
    }
    __device__ __forceinline__ void a_ready(const Unit&) const {}
    __device__ __forceinline__ void done(const Unit&) const {}
};

#define EPI_FOR_AI_M  _Pragma("unroll") for (int ai = 0; ai < 2; ++ai) _Pragma("unroll") for (int m = 0; m < 4; ++m)
#define EPI_ROW (u.pm * BM + ai * HALF + wr * 64 + m * 16 + fr)

struct EpiP1 {
    static constexpr bool PERM = true, AFTER_DRAIN = false, HAS_MID = false;
    bf16_t *XR, *GY, *CQ, *CKV, *KPE, *RAT, *SGB;
    __device__ __forceinline__ void operator()(const f32x4 (&acc)[2][2][4][2], const Unit& u, int wr, int wc, int fr, int fq) const {
        const int pn = u.pn;
        if (pn >= 11) { const int c = (pn - 11) * 128 + wc * 32 + 8 * fq;
            EPI_FOR_AI_M { const size_t off = (size_t)EPI_ROW * 1024 + c; f32x4 r0, r1, s0, s1;
#pragma unroll
                for (int j = 0; j < 4; ++j) { const float ea0 = __builtin_amdgcn_exp2f(-1.4426950408889634f * acc[ai][0][m][0][j]), ea1 = __builtin_amdgcn_exp2f(-1.4426950408889634f * acc[ai][0][m][1][j]);
                    const float eb0 = __builtin_amdgcn_exp2f(-1.4426950408889634f * acc[ai][1][m][0][j]), eb1 = __builtin_amdgcn_exp2f(-1.4426950408889634f * acc[ai][1][m][1][j]);
                    r0[j] = (1.0f + eb0) * __builtin_amdgcn_rcpf(1.0f + ea0); r1[j] = (1.0f + eb1) * __builtin_amdgcn_rcpf(1.0f + ea1); s0[j] = __builtin_amdgcn_rcpf(1.0f + eb0); s1[j] = __builtin_amdgcn_rcpf(1.0f + eb1); }
                *(u32x4*)(RAT + off) = pack8(r0, r1); *(u32x4*)(SGB + off) = pack8(s0, s1); }
            return; }
        bf16_t* base; int ld, colt, act = 0, climit = 256;
        if (pn < 4) { base = XR; ld = 1024; colt = pn * 256; }
        else if (pn < 8) { base = GY; ld = 1024; colt = (pn - 4) * 256; act = 1; }
        else if (pn == 8) { base = CQ; ld = 256; colt = 0; }
        else if (pn == 9) { base = CKV; ld = 256; colt = 0; }
        else { base = KPE; ld = 64; colt = 0; climit = 64; }
        EPI_FOR_AI_M { const size_t row = EPI_ROW;
#pragma unroll
            for (int bj = 0; bj < 2; ++bj) { const int c = bj * HALF + wc * 32 + 8 * fq; f32x4 v0 = acc[ai][bj][m][0], v1 = acc[ai][bj][m][1];
                if (act == 1) { _Pragma("unroll") for (int j = 0; j < 4; ++j) { v0[j] = gelu_tanh(v0[j]); v1[j] = gelu_tanh(v1[j]); } }
                if (c < climit) *(u32x4*)(base + row * ld + colt + c) = pack8(v0, v1); } }
    }
};
struct EpiGates {
    static constexpr bool PERM = true, AFTER_DRAIN = false, HAS_MID = false;
    const bf16_t* XC; const float *ba, *bx, *c8; bf16_t* LOGA; bf16_t* BIN;
    __device__ __forceinline__ void operator()(const f32x4 (&acc)[2][2][4][2], const Unit& u, int wr, int wc, int fr, int fq) const {
        const int ch = u.pn * 128 + wc * 32 + 8 * fq;
#pragma unroll
        for (int n = 0; n < 2; ++n) { const f32x4 br = *(const f32x4*)(ba + ch + 4 * n), bi = *(const f32x4*)(bx + ch + 4 * n), cc = *(const f32x4*)(c8 + ch + 4 * n);
            EPI_FOR_AI_M { const size_t off = (size_t)EPI_ROW * 1024 + ch + 4 * n;
                const u32x2 xw = *(const u32x2*)(XC + off); const f32x4 xv = {bflo(xw.x), bfhi(xw.x), bflo(xw.y), bfhi(xw.y)};
                f32x4 la, bb;
#pragma unroll
                for (int j = 0; j < 4; ++j) { const float r = sigmoidf_(acc[ai][0][m][n][j] + br[j]), ig = sigmoidf_(acc[ai][1][m][n][j] + bi[j]); const float l = -cc[j] * r;
                    const float t = 2.0f * l;
                    const float em = -t * (1.0f + t * (0.5f + t * (0.16666667f + t * (0.041666668f + t * (0.0083333338f + t * 0.0013888889f)))));
                    la[j] = l; bb[j] = xv[j] * ig * __builtin_amdgcn_sqrtf(fmaxf(em, 0.0f)); }
                *(u32x2*)(LOGA + off) = (u32x2){cvtpk_h(la[0], la[1]), cvtpk_h(la[2], la[3])};
                *(u32x2*)(BIN + off) = (u32x2){cvtpk(bb[0], bb[1]), cvtpk(bb[2], bb[3])}; } }
    }
};
struct EpiQ {
    static constexpr bool PERM = true, AFTER_DRAIN = false, HAS_MID = false;
    bf16_t* Q;
    __device__ __forceinline__ void operator()(const f32x4 (&acc)[2][2][4][2], const Unit& u, int wr, int wc, int fr, int fq) const {
        EPI_FOR_AI_M { const size_t row = EPI_ROW;
#pragma unroll
            for (int bj = 0; bj < 2; ++bj) { const int c = bj * HALF + wc * 32 + 8 * fq;
                if (c < QKD) *(u32x4*)(Q + row * (NH * QKD) + u.pn * QKD + c) = pack8(acc[ai][bj][m][0], acc[ai][bj][m][1]); } }
    }
};
struct EpiKV {
    static constexpr bool PERM = true, AFTER_DRAIN = false, HAS_MID = false;
    bf16_t *KN, *V; const float* kg; const float* kpess; float* rsk; PG8_LAS float* xs; PG8_LAS unsigned* cnt;
    __device__ __forceinline__ void operator()(const f32x4 (&acc)[2][2][4][2], const Unit& u, int wr, int wc, int fr, int fq) const {
        PG8_LAS float* xp = xs + wr * 512;
        EPI_FOR_AI_M { const f32x4 a = acc[ai][0][m][0], b = acc[ai][0][m][1]; float s = ((a.x * a.x + a.y * a.y) + (a.z * a.z + a.w * a.w)) + ((b.x * b.x + b.y * b.y) + (b.z * b.z + b.w * b.w));
            s += __shfl_xor(s, 16); s += __shfl_xor(s, 32);
            if (fq == 0) xp[(ai * 64 + m * 16 + fr) * 4 + wc] = s; }
        EPI_FOR_AI_M { const size_t off = (size_t)EPI_ROW * 1024 + u.pn * 128 + wc * 32 + 8 * fq; *(u32x4*)(V + off) = pack8(acc[ai][1][m][0], acc[ai][1][m][1]); }
        asm volatile("s_waitcnt lgkmcnt(0)" ::: "memory");
        unsigned old = 0u; if (fr == 0 && fq == 0) old = __hip_atomic_fetch_add(cnt + wr, 1u, __ATOMIC_RELAXED, __HIP_MEMORY_SCOPE_WORKGROUP);
        const unsigned target = ((unsigned)__builtin_amdgcn_readfirstlane((int)old) / 4u + 1u) * 4u;
        while (__hip_atomic_load(cnt + wr, __ATOMIC_RELAXED, __HIP_MEMORY_SCOPE_WORKGROUP) < target) __builtin_amdgcn_s_sleep(1);
        asm volatile("" ::: "memory");
        const f32x4 g0 = *(const f32x4*)(kg + wc * 32 + 8 * fq), g1 = *(const f32x4*)(kg + wc * 32 + 8 * fq + 4);
        EPI_FOR_AI_M { const size_t row = EPI_ROW; const f32x4 p = *(const PG8_LAS f32x4*)(xp + (ai * 64 + m * 16 + fr) * 4);
            const float rs = 1.0f / sqrtf((((p.x + p.y) + (p.z + p.w)) + kpess[row]) * (1.0f / 192.0f) + EPS);
            *(u32x4*)(KN + row * 1024 + u.pn * 128 + wc * 32 + 8 * fq) = pack8(acc[ai][0][m][0] * rs * g0, acc[ai][0][m][1] * rs * g1);
            if (wc == 0 && fq == 0) rsk[row * 8 + u.pn] = rs; }
    }
};
struct EpiPlain {
    static constexpr bool PERM = true, AFTER_DRAIN = false, HAS_MID = false;
    bf16_t* O; int ldc;
    __device__ __forceinline__ void operator()(const f32x4 (&acc)[2][2][4][2], const Unit& u, int wr, int wc, int fr, int fq) const {
        EPI_FOR_AI_M { const size_t row = EPI_ROW;
#pragma unroll
            for (int bj = 0; bj < 2; ++bj) *(u32x4*)(O + row * ldc + u.pn * BM + bj * HALF + wc * 32 + 8 * fq) = pack8(acc[ai][bj][m][0], acc[ai][bj][m][1]); }
    }
};
struct EpiMerge {
    static constexpr bool PERM = true, AFTER_DRAIN = false, HAS_MID = true;
    const bf16_t *RAT, *SGB; bf16_t* MG;
    __device__ __forceinline__ void mid(f32x4 (&acc)[2][2][4][2], const Unit& u, int wr, int wc, int fr, int fq) const {
        asm volatile("" : "+v"(fr), "+v"(fq));
        EPI_FOR_AI_M { const size_t row = EPI_ROW;
#pragma unroll
            for (int bj = 0; bj < 2; ++bj) { const size_t off = row * 1024 + u.pn * BM + bj * HALF + wc * 32 + 8 * fq;
                f32x4 g0, g1; unpack8(*(const u32x4*)(RAT + off), g0, g1);
                acc[ai][bj][m][0] = acc[ai][bj][m][0] * g0; acc[ai][bj][m][1] = acc[ai][bj][m][1] * g1; }
            asm volatile("" ::: "memory"); }
    }
    __device__ __forceinline__ void operator()(const f32x4 (&acc)[2][2][4][2], const Unit& u, int wr, int wc, int fr, int fq) const {
        EPI_FOR_AI_M { const size_t row = EPI_ROW;
#pragma unroll
            for (int bj = 0; bj < 2; ++bj) { const size_t off = row * 1024 + u.pn * BM + bj * HALF + wc * 32 + 8 * fq;
                f32x4 s0, s1; unpack8(*(const u32x4*)(SGB + off), s0, s1);
                *(u32x4*)(MG + off) = pack8(s0 * acc[ai][bj][m][0], s1 * acc[ai][bj][m][1]); } }
    }
};
struct EpiResH {
    static constexpr bool PERM = true, AFTER_DRAIN = false, HAS_MID = false;
    const float* X; bf16_t* H;
    __device__ __forceinline__ void operator()(const f32x4 (&acc)[2][2][4][2], const Unit& u, int wr, int wc, int fr, int fq) const {
        EPI_FOR_AI_M { const size_t row = EPI_ROW;
#pragma unroll
            for (int bj = 0; bj < 2; ++bj) { const size_t off = row * 1024 + u.pn * BM + bj * HALF + wc * 32 + 8 * fq;
                const f32x4 x0 = *(const f32x4*)(X + off), x1 = *(const f32x4*)(X + off + 4);
                *(u32x4*)(H + off) = pack8(x0 + acc[ai][bj][m][0], x1 + acc[ai][bj][m][1]); } }
    }
};
struct EpiUp {
    static constexpr bool PERM = true, AFTER_DRAIN = false, HAS_MID = false;
    bf16_t* HS; const float* rsl;
    __device__ __forceinline__ void operator()(const f32x4 (&acc)[2][2][4][2], const Unit& u, int wr, int wc, int fr, int fq) const {
        const float* rp = rsl + (size_t)(u.ex & 255) * 32768 + (u.ex >> 8) * 256;
        EPI_FOR_AI_M { const size_t off = (size_t)EPI_ROW * DE + u.pn * 128 + wc * 32 + 8 * fq; const float rs = rp[ai * HALF + wr * 64 + m * 16 + fr];
            f32x4 h0, h1;
#pragma unroll
            for (int j = 0; j < 4; ++j) { const float a0 = rs * acc[ai][0][m][0][j], a1 = rs * acc[ai][0][m][1][j]; h0[j] = a0 * sigmoidf_(a0) * (rs * acc[ai][1][m][0][j]); h1[j] = a1 * sigmoidf_(a1) * (rs * acc[ai][1][m][1][j]); }
            *(u32x4*)(HS + off) = pack8(h0, h1); }
    }
};
struct EpiDown {
    static constexpr bool PERM = true, AFTER_DRAIN = false, HAS_MID = false;
    bf16_t* YS; const float* glist;
    __device__ __forceinline__ void operator()(const f32x4 (&acc)[2][2][4][2], const Unit& u, int wr, int wc, int fr, int fq) const {
        const float* gp = glist + (size_t)(u.ex & 255) * 32768 + (u.ex >> 8) * 256;
        EPI_FOR_AI_M { const size_t row = EPI_ROW; const float g = gp[ai * HALF + wr * 64 + m * 16 + fr];
#pragma unroll
            for (int bj = 0; bj < 2; ++bj) *(u32x4*)(YS + row * 1024 + u.pn * BM + bj * HALF + wc * 32 + 8 * fq) = pack8(acc[ai][bj][m][0] * g, acc[ai][bj][m][1] * g); }
    }
};
#undef EPI_FOR_AI_M
#undef EPI_ROW
}

namespace att {
constexpr int SHM_V = 16384, SHM_KN = 16384, SHM_KR = 8192;
constexpr int OFF_V = 0, OFF_KN = 3 * SHM_V, OFF_KR = OFF_KN + 2 * SHM_KN, OFF_WS = OFF_KR + 2 * SHM_KR, OFF_QR = OFF_WS + 8 * 64 * 4, ATT_LDS = OFF_QR + 8 * 4096;
static_assert(ATT_LDS <= L_BARST, "attention LDS stays below the grid barrier words");
constexpr float THR = 8.0f;
#define KSWZ(row, colB) ((row) * 256 + ((colB) ^ (((row) & 15) << 4)))
#define KRSWZ(row, ch) (((row) >> 1) * 256 + (((((row) & 1) << 3) + (ch)) ^ (((row) >> 1) & 7)) * 16)
#define SBAR() __builtin_amdgcn_sched_barrier(0)
__device__ __forceinline__ int v_st(int k, int c) { const int kk = (k & ~0xC) | ((k & 4) << 1) | ((k & 8) >> 1); return ((kk >> 3) * 4 + (c >> 5)) * 512 + ((kk & 7) * 32 + (c & 31)) * 2; }
__device__ __forceinline__ int v_rd_base(int lane) { return ((lane & 3) << 3) | (((lane >> 2) & 3) << 6) | (((lane >> 4) & 1) << 5) | (((lane >> 5) & 1) << 8); }
constexpr int v_rd_off(int d0, int ks, int half) { return d0 * 512 + ks * 4096 + half * 2048; }
__device__ __forceinline__ int crow(int r, int hi) { return (r & 3) + 8 * (r >> 2) + 4 * hi; }
__device__ __forceinline__ unsigned cvtpk_a(float lo, float hi) { unsigned r; asm volatile("v_cvt_pk_bf16_f32 %0, %1, %2" : "=v"(r) : "v"(lo), "v"(hi)); return r; }

__device__ __forceinline__ void mask_tile(f32x16& p0, f32x16& p1, int dq) {
    const float NEG = -__builtin_inff();
#pragma unroll
    for (int r = 0; r < 16; ++r) {
        const int c = (r & 3) + 8 * (r >> 2);
        if (dq - c < 0) p0[r] = NEG;
        if (dq - c - 32 < 0) p1[r] = NEG;
    }
}
__device__ __forceinline__ void partialSM(f32x16& p0, f32x16& p1, float& m_reg, float& alpha) {
    float pmax = p0[0];
#pragma unroll
    for (int r = 1; r < 16; ++r) pmax = fmaxf(pmax, p0[r]);
#pragma unroll
    for (int r = 0; r < 16; ++r) pmax = fmaxf(pmax, p1[r]);
    { auto rr = __builtin_amdgcn_permlane32_swap(__float_as_uint(pmax), __float_as_uint(pmax), false, false);
      pmax = fmaxf(__uint_as_float(rr[0]), __uint_as_float(rr[1])); }
    float mn;
    if (__builtin_expect(__all((pmax - m_reg) <= THR), 1)) { mn = m_reg; alpha = 1.f; }
    else { mn = fmaxf(m_reg, pmax); alpha = __builtin_amdgcn_exp2f(m_reg - mn); m_reg = mn; }
#pragma unroll
    for (int r = 0; r < 16; ++r) p0[r] = __builtin_amdgcn_exp2f(p0[r] - mn);
#pragma unroll
    for (int r = 0; r < 16; ++r) p1[r] = __builtin_amdgcn_exp2f(p1[r] - mn);
}
__device__ __forceinline__ void partialSM_rel(f32x16& p0, f32x16& p1, float& m_reg, float& alpha) {
    float pmax = p0[0];
#pragma unroll
    for (int r = 1; r < 16; ++r) pmax = fmaxf(pmax, p0[r]);
#pragma unroll
    for (int r = 0; r < 16; ++r) pmax = fmaxf(pmax, p1[r]);
    { auto rr = __builtin_amdgcn_permlane32_swap(__float_as_uint(pmax), __float_as_uint(pmax), false, false);
      pmax = fmaxf(__uint_as_float(rr[0]), __uint_as_float(rr[1])); }
    if (__builtin_expect(__all(pmax <= THR), 1)) { alpha = 1.f; }
    else { const float dl = fmaxf(pmax, 0.f); alpha = __builtin_amdgcn_exp2f(-dl); m_reg += dl;
#pragma unroll
        for (int r = 0; r < 16; ++r) { p0[r] -= dl; p1[r] -= dl; } }
#pragma unroll
    for (int r = 0; r < 16; ++r) p0[r] = __builtin_amdgcn_exp2f(p0[r]);
#pragma unroll
    for (int r = 0; r < 16; ++r) p1[r] = __builtin_amdgcn_exp2f(p1[r]);
}
__device__ __forceinline__ void finishSM(f32x16& p0, f32x16& p1, float alpha, float& l_reg, bf16x8& pa0, bf16x8& pa1, bf16x8& pa2, bf16x8& pa3) {
    float ps = 0;
#pragma unroll
    for (int r = 0; r < 16; ++r) ps += p0[r];
#pragma unroll
    for (int r = 0; r < 16; ++r) ps += p1[r];
    { auto rr = __builtin_amdgcn_permlane32_swap(__float_as_uint(ps), __float_as_uint(ps), false, false);
      ps = __uint_as_float(rr[0]) + __uint_as_float(rr[1]); }
    l_reg = l_reg * alpha + ps;
#define PK4(P, B_, OUT) do { unsigned a0 = cvtpk_a(P[B_+0], P[B_+1]), a1 = cvtpk_a(P[B_+2], P[B_+3]);                          \
        unsigned b0 = cvtpk_a(P[B_+4], P[B_+5]), b1 = cvtpk_a(P[B_+6], P[B_+7]);                                             \
        auto r0 = __builtin_amdgcn_permlane32_swap(a0, b0, false, false); auto r1 = __builtin_amdgcn_permlane32_swap(a1, b1, false, false); \
        u32x4 w = {r0[0], r1[0], r0[1], r1[1]}; OUT = *reinterpret_cast<bf16x8*>(&w); } while (0)
    PK4(p0, 0, pa0); PK4(p0, 8, pa1); PK4(p1, 0, pa2); PK4(p1, 8, pa3);
#undef PK4
}
template <int KB>
__device__ __forceinline__ void qkt(f32x16& p0, f32x16& p1, const char* lds, int r32, int hi, const bf16x8* qr, const char* qrl, float c0) {
#pragma unroll
    for (int r = 0; r < 16; ++r) { p0[r] = c0; p1[r] = c0; }
    int sw = (r32 & 15) << 4; asm volatile("" : "+v"(sw));
    const char* kbase = lds + OFF_KN + KB * SHM_KN + r32 * 256; const char* krb[4];
#pragma unroll
    for (int dd = 0; dd < 4; ++dd) krb[dd] = lds + OFF_KR + KB * SHM_KR + KRSWZ(r32, dd * 2 + hi);
#pragma unroll
    for (int d0 = 0; d0 < 8; ++d0) { const char* a = kbase + (((d0 * 16 + hi * 8) * 2) ^ sw);
        bf16x8 b0 = *reinterpret_cast<const bf16x8*>(a);
        bf16x8 b1 = *reinterpret_cast<const bf16x8*>(a + 32 * 256);
        p0 = __builtin_amdgcn_mfma_f32_32x32x16_bf16(b0, qr[d0], p0, 0, 0, 0);
        p1 = __builtin_amdgcn_mfma_f32_32x32x16_bf16(b1, qr[d0], p1, 0, 0, 0); }
#pragma unroll
    for (int dd = 0; dd < 4; ++dd) {
        bf16x8 b0 = *reinterpret_cast<const bf16x8*>(krb[dd]);
        bf16x8 b1 = *reinterpret_cast<const bf16x8*>(krb[dd] + 16 * 256);
        const bf16x8 qf = *reinterpret_cast<const bf16x8*>(qrl + KRSWZ(r32, dd * 2 + hi));
        p0 = __builtin_amdgcn_mfma_f32_32x32x16_bf16(b0, qf, p0, 0, 0, 0);
        p1 = __builtin_amdgcn_mfma_f32_32x32x16_bf16(b1, qf, p1, 0, 0, 0); }
}
template <int VB>
__device__ __forceinline__ void pv_tile(f32x16* o, int vb0, bf16x8 pa0, bf16x8 pa1, bf16x8 pa2, bf16x8 pa3) {
#define TRRD(dst, off) asm volatile("ds_read_b64_tr_b16 %0, %1 offset:%2" : "=&v"(dst) : "v"(vb0), "i"(off) : "memory")
#define PV_D0(d0) do { s16x4 l0, l1, l2, l3, h0, h1, h2, h3; constexpr int b_ = OFF_V + VB * SHM_V + v_rd_off(d0, 0, 0);     \
        TRRD(l0, b_); TRRD(h0, b_ + 2048); TRRD(l1, b_ + 4096); TRRD(h1, b_ + 6144); TRRD(l2, b_ + 8192); TRRD(h2, b_ + 10240); TRRD(l3, b_ + 12288); TRRD(h3, b_ + 14336); \
        asm volatile("s_waitcnt lgkmcnt(0)" ::: "memory"); SBAR();   \
        o[d0] = __builtin_amdgcn_mfma_f32_32x32x16_bf16(pa0, (bf16x8){l0[0], l0[1], l0[2], l0[3], h0[0], h0[1], h0[2], h0[3]}, o[d0], 0, 0, 0);   \
        o[d0] = __builtin_amdgcn_mfma_f32_32x32x16_bf16(pa1, (bf16x8){l1[0], l1[1], l1[2], l1[3], h1[0], h1[1], h1[2], h1[3]}, o[d0], 0, 0, 0);   \
        o[d0] = __builtin_amdgcn_mfma_f32_32x32x16_bf16(pa2, (bf16x8){l2[0], l2[1], l2[2], l2[3], h2[0], h2[1], h2[2], h2[3]}, o[d0], 0, 0, 0);   \
        o[d0] = __builtin_amdgcn_mfma_f32_32x32x16_bf16(pa3, (bf16x8){l3[0], l3[1], l3[2], l3[3], h3[0], h3[1], h3[2], h3[3]}, o[d0], 0, 0, 0); } while (0)
    PV_D0(0); PV_D0(1); PV_D0(2); PV_D0(3);
#undef PV_D0
#undef TRRD
}
__device__ __forceinline__ void attn_block(int b, int h, int qb, const bf16_t* Q, const bf16_t* KN, const bf16_t* KR, const bf16_t* V, bf16_t* O, char* lds, LAS unsigned char* ldsl, const float* qg, const float* CS, int wid_in) {
    const int wid = wid_in; int lane_ = lane_id_v();
    const int lane = lane_, tid = wid * 64 + lane, r32 = lane & 31, hi = lane >> 5;
    const size_t tok0 = (size_t)b * SEQ; const int q0 = qb * 256; const int NT = 4 * qb + 4;
    const int qlo = q0 + wid * 32, qm = qlo + r32 - 4 * hi;
    float* wsf = (float*)(lds + OFF_WS) + wid * 64; float* li_l = wsf, * al_l = wsf + 32;
    bf16x8 qr[12];
    { const bf16_t* qrow = Q + ((tok0 + qlo + r32) * NH + h) * QKD + hi * 8;
#pragma unroll
      for (int d0 = 0; d0 < 12; ++d0) qr[d0] = *reinterpret_cast<const bf16x8*>(qrow + d0 * 16);
      float ss = 0.f;
#pragma unroll
      for (int d0 = 0; d0 < 12; ++d0) { f32x4 a, b; unpack8(__builtin_bit_cast(u32x4, qr[d0]), a, b); ss += (a.x * a.x + a.y * a.y) + (a.z * a.z + a.w * a.w) + (b.x * b.x + b.y * b.y) + (b.z * b.z + b.w * b.w); }
      ss += __shfl_xor(ss, 32);
      const float rs = QSCALE / sqrtf(ss * (1.0f / 192.0f) + EPS);
      const float* gp = qg + hi * 8;
#pragma unroll
      for (int d0 = 0; d0 < 8; ++d0) { f32x4 a, b; unpack8(__builtin_bit_cast(u32x4, qr[d0]), a, b); const f32x4 g0 = *(const f32x4*)(gp + d0 * 16), g1 = *(const f32x4*)(gp + d0 * 16 + 4);
          qr[d0] = __builtin_bit_cast(bf16x8, pack8(a * rs * g0, b * rs * g1)); }
      const float* cs = CS + (tok0 + qlo + r32) * 64 + hi * 8;
#pragma unroll
      for (int dd = 0; dd < 2; ++dd) { f32x4 a1, b1, a2, b2; unpack8(__builtin_bit_cast(u32x4, qr[8 + dd]), a1, b1); unpack8(__builtin_bit_cast(u32x4, qr[10 + dd]), a2, b2);
          const f32x4 g10 = *(const f32x4*)(gp + 128 + dd * 16), g11 = *(const f32x4*)(gp + 128 + dd * 16 + 4), g20 = *(const f32x4*)(gp + 160 + dd * 16), g21 = *(const f32x4*)(gp + 160 + dd * 16 + 4);
          const f32x4 c0 = *(const f32x4*)(cs + dd * 16), c1 = *(const f32x4*)(cs + dd * 16 + 4), s0 = *(const f32x4*)(cs + 32 + dd * 16), s1 = *(const f32x4*)(cs + 32 + dd * 16 + 4);
          a1 = a1 * rs * g10; b1 = b1 * rs * g11; a2 = a2 * rs * g20; b2 = b2 * rs * g21;
          qr[8 + dd] = __builtin_bit_cast(bf16x8, pack8(a1 * c0 - a2 * s0, b1 * c1 - b2 * s1)); qr[10 + dd] = __builtin_bit_cast(bf16x8, pack8(a2 * c0 + a1 * s0, b2 * c1 + b1 * s1)); }
#pragma unroll
      for (int dd = 0; dd < 4; ++dd) *reinterpret_cast<bf16x8*>(lds + OFF_QR + wid * 4096 + KRSWZ(r32, dd * 2 + hi)) = qr[8 + dd]; }
    const char* qrl = lds + OFF_QR + wid * 4096;
    const char* knb = (const char*)(KN + tok0 * 1024 + h * 128); const char* vbs = (const char*)(V + tok0 * 1024 + h * 128); const char* krbs = (const char*)(KR + (tok0 * NH + h) * ROPE);
    unsigned so_k[2], so_v[2], so_r;
#pragma unroll
    for (int i = 0; i < 2; ++i) { const int pp = wid * 2 + i;
        { const int row = 4 * pp + (lane >> 4), c = (lane & 15) ^ (row & 15); so_k[i] = (unsigned)(row * 2048 + c * 16); }
        { const int st = 2 * pp + (lane >> 5), kk = (st >> 2) * 8 + ((lane >> 2) & 7), k = (kk & ~0xC) | ((kk & 4) << 1) | ((kk & 8) >> 1), col = (st & 3) * 32 + (lane & 3) * 8; so_v[i] = (unsigned)(k * 2048 + col * 2); } }
    { const int pair = 4 * wid + (lane >> 4), sl = (lane & 15) ^ (pair & 7), row = 2 * pair + (sl >> 3); so_r = (unsigned)(row * (NH * ROPE * 2) + (sl & 7) * 16); }
    const int vb0 = (int)(uintptr_t)lds + v_rd_base(lane);
#define DMA_K(t, kb_) do { const char* k_ = knb + (size_t)(t) * 64 * 1024 * 2; const char* r_ = krbs + (size_t)(t) * 64 * NH * ROPE * 2; \
        _Pragma("unroll") for (int i_ = 0; i_ < 2; ++i_) __builtin_amdgcn_global_load_lds((const unsigned*)(k_ + so_k[i_]), (LAS unsigned*)(ldsl + OFF_KN + (kb_) * SHM_KN + (wid * 2 + i_) * 1024), 16, 0, 0); \
        __builtin_amdgcn_global_load_lds((const unsigned*)(r_ + so_r), (LAS unsigned*)(ldsl + OFF_KR + (kb_) * SHM_KR + wid * 1024), 16, 0, 0); } while (0)
#define DMA_V(t, vo_) do { const char* v_ = vbs + (size_t)(t) * 64 * 1024 * 2; \
        _Pragma("unroll") for (int i_ = 0; i_ < 2; ++i_) __builtin_amdgcn_global_load_lds((const unsigned*)(v_ + so_v[i_]), (LAS unsigned*)(ldsl + OFF_V + (vo_) + (wid * 2 + i_) * 1024), 16, 0, 0); } while (0)
#define VMW() asm volatile("s_waitcnt vmcnt(0)" ::: "memory")
    float m_reg = -1e30f, l_reg = 0.f; f32x16 o[4] = {};
    f32x16 pA0, pA1, pB0, pB1; bf16x8 pa0, pa1, pa2, pa3; float alA, alB;
#define RESC(a) do { if (__any((a) < 1.f)) { if (hi == 0) al_l[r32] = (a); asm volatile("s_waitcnt lgkmcnt(0)" ::: "memory");              \
                     _Pragma("unroll") for (int d_ = 0; d_ < 4; ++d_) _Pragma("unroll") for (int r = 0; r < 16; ++r) o[d_][r] *= al_l[crow(r, hi)]; } } while (0)
#define MASKT(P0_, P1_, t) do { const int kb_ = (t) * 64; if (kb_ + 63 > qlo) mask_tile(P0_, P1_, qm - kb_); } while (0)
    int vo_prev = 0, vo_cur = 0, vo_next = SHM_V;
#define ROTV() do { vo_prev = vo_cur; vo_cur = vo_next; vo_next = (vo_next == 2 * SHM_V) ? 0 : vo_next + SHM_V; } while (0)
    DMA_K(0, 0); DMA_V(0, 0); VMW(); __syncthreads();
    DMA_K(1, 1); DMA_V(1, SHM_V); SBAR();
    qkt<0>(pA0, pA1, lds, r32, hi, qr, qrl, 0.f); MASKT(pA0, pA1, 0); partialSM(pA0, pA1, m_reg, alA);
    VMW(); __syncthreads(); ROTV();
#define HALF_STEP(PX0, PX1, alX, PY0, PY1, alY, t, KB) do { const bool more = (t) + 1 < NT;                     \
        if (more) { DMA_K((t) + 1, (KB) ^ 1); DMA_V((t) + 1, vo_next); } SBAR();                                   \
        qkt<KB>(PX0, PX1, lds, r32, hi, qr, qrl, -m_reg);                                                              \
        finishSM(PY0, PY1, alY, l_reg, pa0, pa1, pa2, pa3); SBAR();                                              \
        pv_tile<0>(o, vb0 + vo_prev, pa0, pa1, pa2, pa3);                                                         \
        MASKT(PX0, PX1, t); partialSM_rel(PX0, PX1, m_reg, alX); RESC(alX);                                       \
        VMW(); __syncthreads(); ROTV(); } while (0)
    for (int t = 1; t + 1 < NT; t += 2) {
        HALF_STEP(pB0, pB1, alB, pA0, pA1, alA, t, 1);
        HALF_STEP(pA0, pA1, alA, pB0, pB1, alB, t + 1, 0);
    }
    HALF_STEP(pB0, pB1, alB, pA0, pA1, alA, NT - 1, 1);
    finishSM(pB0, pB1, alB, l_reg, pa0, pa1, pa2, pa3); SBAR();
    pv_tile<0>(o, vb0 + vo_prev, pa0, pa1, pa2, pa3);
    if (hi == 0) li_l[r32] = l_reg; asm volatile("s_waitcnt lgkmcnt(0)" ::: "memory");
    float rli[16];
#pragma unroll
    for (int r = 0; r < 16; ++r) rli[r] = __builtin_amdgcn_rcpf(li_l[crow(r, hi)]);
    int hi_o = hi; asm volatile("" : "+v"(hi_o));
    bf16_t* Ow = O + (tok0 + qlo + 4 * hi_o) * 1024 + h * 128 + r32;
#pragma unroll
    for (int r = 0; r < 16; ++r) { const int orow = (r & 3) + 8 * (r >> 2);
#pragma unroll
        for (int d0 = 0; d0 < 4; ++d0) { const float v = o[d0][r] * rli[r]; const float vn = __shfl_xor(v, 1);
            if ((r32 & 1) == 0) *(unsigned*)(Ow + orow * 1024 + d0 * 32) = cvtpk(v, vn); } }
    __syncthreads();
#undef DMA_K
#undef DMA_V
#undef MASKT
#undef ROTV
#undef HALF_STEP
#undef VMW
#undef RESC
}
#undef KSWZ
#undef KRSWZ
#undef SBAR
}

__device__ __forceinline__ void tr_load(float (&v)[32], const float* src, size_t lsrc, int lane) {
    asm volatile("" : "+v"(lane));
    const float* sp = src + (size_t)(lane >> 5) * lsrc + (lane & 31);
#pragma unroll
    for (int i = 0; i < 32; ++i) v[i] = sp[(size_t)(2 * i) * lsrc];
}
__device__ __forceinline__ void tr_finish(const float (&v)[32], bf16_t* dst, size_t ldd, LAS float* scr, int lane, const float* gk = nullptr) {
#pragma unroll
    for (int i = 0; i < 32; ++i) scr[(2 * i + (lane >> 5)) * 33 + (lane & 31)] = v[i];
    LDS_WAIT(); asm volatile("" ::: "memory");
    const int c = lane & 7;
    f32x4 g0 = {1.f, 1.f, 1.f, 1.f}, g1 = g0;
    if (gk) { g0 = *(const f32x4*)(gk + 8 * c); g1 = *(const f32x4*)(gk + 8 * c + 4); }
#pragma unroll
    for (int j = 0; j < 4; ++j) { const int n = (lane >> 3) + 8 * j; const LAS float* s = scr + (8 * c) * 33 + n;
        u32x4 o; o.x = cvtpk(s[0 * 33] * g0.x, s[1 * 33] * g0.y); o.y = cvtpk(s[2 * 33] * g0.z, s[3 * 33] * g0.w); o.z = cvtpk(s[4 * 33] * g1.x, s[5 * 33] * g1.y); o.w = cvtpk(s[6 * 33] * g1.z, s[7 * 33] * g1.w);
        *(u32x4*)(dst + (size_t)n * ldd + 8 * c) = o; }
    LDS_WAIT(); asm volatile("" ::: "memory");
}
__device__ __forceinline__ void tr_item(const float* src, size_t lsrc, bf16_t* dst, size_t ldd, LAS float* scr, int lane) { float v[32]; tr_load(v, src, lsrc, lane); tr_finish(v, dst, ldd, scr, lane); }
__device__ __forceinline__ void rms_row_to_bf16(const float* xrow, const float* g, bf16_t* orow, int lane) {
    f32x4 v[4]; float s = 0.f;
#pragma unroll
    for (int j = 0; j < 4; ++j) { v[j] = *(const f32x4*)(xrow + 4 * lane + 256 * j); s += (v[j].x * v[j].x + v[j].y * v[j].y) + (v[j].z * v[j].z + v[j].w * v[j].w); }
    const float rs = 1.0f / sqrtf(wave_sum(s) * (1.0f / 1024.0f) + EPS);
#pragma unroll
    for (int j = 0; j < 4; ++j) { const f32x4 gg = *(const f32x4*)(g + 4 * lane + 256 * j); const f32x4 y = v[j] * rs * gg;
        *(u32x2*)(orow + 4 * lane + 256 * j) = (u32x2){cvtpk(y.x, y.y), cvtpk(y.z, y.w)}; }
}

__device__ __forceinline__ void rms_row2_to_bf16(const float* xa, const float* xb, const float* g, bf16_t* oa, bf16_t* ob, int lane) {
    f32x4 va[4], vb[4]; float sa = 0.f, sb = 0.f;
#pragma unroll
    for (int j = 0; j < 4; ++j) { va[j] = *(const f32x4*)(xa + 4 * lane + 256 * j); vb[j] = *(const f32x4*)(xb + 4 * lane + 256 * j); }
#pragma unroll
    for (int j = 0; j < 4; ++j) { sa += (va[j].x * va[j].x + va[j].y * va[j].y) + (va[j].z * va[j].z + va[j].w * va[j].w); sb += (vb[j].x * vb[j].x + vb[j].y * vb[j].y) + (vb[j].z * vb[j].z + vb[j].w * vb[j].w); }
    const float ra = 1.0f / sqrtf(wave_sum(sa) * (1.0f / 1024.0f) + EPS), rb = 1.0f / sqrtf(wave_sum(sb) * (1.0f / 1024.0f) + EPS);
#pragma unroll
    for (int j = 0; j < 4; ++j) { const f32x4 gg = *(const f32x4*)(g + 4 * lane + 256 * j); const f32x4 ya = va[j] * ra * gg, yb = vb[j] * rb * gg;
        *(u32x2*)(oa + 4 * lane + 256 * j) = (u32x2){cvtpk(ya.x, ya.y), cvtpk(ya.z, ya.w)}; *(u32x2*)(ob + 4 * lane + 256 * j) = (u32x2){cvtpk(yb.x, yb.y), cvtpk(yb.z, yb.w)}; }
}
__device__ __forceinline__ void p1b_rope_table(Frame& F, const Args& A, int part, int nparts) {
    const int gt = (part * 8 + F.wave) * 64 + F.lane, GT = nparts * 8 * 64;
    { float* CS = (float*)((unsigned char*)F.out + OUT_CS); const int* pos = (const int*)A.in[1];
      for (int i = gt; i < NTOK * 32; i += GT) { const int tok = i >> 5, fi = i & 31; const float ang = (float)pos[tok] * A.invf[fi];
          const float kq = __builtin_rintf(ang * 0.15915494309189535f);
          float rr = __builtin_fmaf(-kq, 6.28318548202514648f, ang); rr = __builtin_fmaf(-kq, -1.74845553e-7f, rr);
          const float fr = rr * 0.15915494309189535f;
          CS[tok * 64 + fi] = __builtin_amdgcn_cosf(fr); CS[tok * 64 + 32 + fi] = __builtin_amdgcn_sinf(fr); } }
}
constexpr int P0_I_IN = 16 * 146, P0_I_SQ = 16 * 32, P0_I_UQ = 4 * 48, P0_I_UKV = 4 * 64, P0_I_G = 64;
constexpr int P0_NITEMS = P0_I_IN + 3 * P0_I_SQ + P0_I_UQ + P0_I_UKV + 2 * P0_I_G;
__device__ __forceinline__ void p0_copies(Frame& F, const Args& A, int it_lo, int it_hi, int gw, int ngw) {
    LAS float* scr = (LAS float*)(F.lds + F.wave * 16384);
    unsigned char* ws = F.ws;
    bf16_t* WinT = (bf16_t*)(ws + WS_WIN); bf16_t* WuqT = (bf16_t*)(ws + WS_WUQ); bf16_t* Wgate = (bf16_t*)(ws + WS_WGATE);
    constexpr int I_IN = P0_I_IN, I_SQ = P0_I_SQ, I_UQ = P0_I_UQ, I_UKV = P0_I_UKV, I_G = P0_I_G;
    __syncthreads();
    for (int it = it_lo + gw; it < it_hi; it += ngw) {
        int r = it;
        if (r < I_IN) { const int kb = r / 146, nb = r % 146, n0 = 32 * nb;
            const int dr = n0 < 2624 ? n0 : (n0 < 3648 ? 2816 + 256 * ((n0 - 2624) >> 7) + ((n0 - 2624) & 127) : 2816 + 256 * ((n0 - 3648) >> 7) + 128 + ((n0 - 3648) & 127));
            tr_item((const float*)A.in[3] + (size_t)(64 * kb) * 4672 + n0, 4672, WinT + (size_t)dr * 1024 + 64 * kb, 1024, scr, F.lane); continue; } r -= I_IN;
        if (r < 3 * I_SQ) { const int w = r / I_SQ, q = r % I_SQ, kb = q / 32, nb = q % 32; const float* src = (const float*)A.in[w == 0 ? 11 : (w == 1 ? 18 : 19)];
            bf16_t* dst = (bf16_t*)(ws + (w == 2 ? WS_WOUT : WS_WRNN)) + (w == 1 ? 1024 : 0); const size_t ldd = (w == 2) ? 1024 : 2048;
            tr_item(src + (size_t)(64 * kb) * 1024 + 32 * nb, 1024, dst + (size_t)(32 * nb) * ldd + 64 * kb, ldd, scr, F.lane); continue; } r -= 3 * I_SQ;
        if (r < I_UQ) { const int kb = r / 48, nb = r % 48, n0 = 32 * nb;
            tr_item((const float*)A.in[13] + (size_t)(64 * kb) * 1536 + n0, 1536, WuqT + (size_t)n0 * 256 + 64 * kb, 256, scr, F.lane); continue; } r -= I_UQ;
        if (r < I_UKV) { const int kb = r / 64, nb = r % 64;
            tr_item((const float*)A.in[15] + (size_t)(64 * kb) * 2048 + 32 * nb, 2048, (bf16_t*)(ws + WS_WUKV) + (size_t)(32 * nb) * 256 + 64 * kb, 256, scr, F.lane); continue; } r -= I_UKV;
        { const int which = r / I_G, q = r % I_G, blk = q / 8, kb = (q % 8) / 4, nb = q % 4;
          const float* src = (const float*)A.in[which == 0 ? 6 : 8] + (size_t)blk * 128 * 128 + (size_t)(64 * kb) * 128 + 32 * nb;
          tr_item(src, 128, Wgate + (size_t)(blk * 256 + which * 128 + 32 * nb) * 128 + 64 * kb, 128, scr, F.lane); }
    }
}
__device__ __forceinline__ void p0_prologue(Frame& F, const Args& A) {
    unsigned char* ws = F.ws; bf16_t* WinT = (bf16_t*)(ws + WS_WIN);
    const float* x = (const float*)A.in[0];
    f32x4 v[4][4];
#define P0_LOADROWS(dst, m_) do { _Pragma("unroll") for (int i = 0; i < 4; ++i) _Pragma("unroll") for (int j = 0; j < 4; ++j) dst[i][j] = *(const f32x4*)(x + (size_t)((m_) + i * F.NGW) * DM + 4 * F.lane + 256 * j); } while (0)
    P0_LOADROWS(v, F.gw);
    p0_copies(F, A, 0, P0_I_IN, F.gw, F.NGW);
#ifdef PROBE_P0
    STAMPX(F, 3);
#endif
    const int gt = F.gw * 64 + F.lane, GT = F.NGW * 64; const u32x4 z4 = {0u, 0u, 0u, 0u};
    for (int i = gt; i < 192 * 128; i += GT) *(u32x4*)(WinT + (size_t)2624 * 1024 + (size_t)i * 8) = z4;
    float* c8 = (float*)(ws + WS_C8); float* Wr = (float*)(ws + WS_WR); float* br = (float*)(ws + WS_BR);
    for (int i = gt; i < 1024; i += GT) c8[i] = 8.0f * log1pf(expf(-((const float*)A.in[10])[i]));
    { bf16_t* WrH = (bf16_t*)Wr; bf16_t* WrL = WrH + 96 * 1024;
      for (int i = gt; i < 1024 * 96; i += GT) { const int c = i >> 10, k = i & 1023; const float w = ((const float*)A.in[20])[k] * (c < 8 ? ((const float*)A.in[21])[k * 8 + c] : (c < 72 ? ((const float*)A.in[23])[k * 64 + c - 8] : 0.f));
          const unsigned hb = cvtpk(w, 0.f) & 0xffffu; const float lo = w - __uint_as_float(hb << 16); WrH[i] = (bf16_t)hb; WrL[i] = (bf16_t)(cvtpk(lo, 0.f) & 0xffffu); } }
    for (int i = gt; i < 72; i += GT) br[i] = i < 8 ? ((const float*)A.in[22])[i] : ((const float*)A.in[24])[i - 8];
    bf16_t* U = (bf16_t*)(ws + WS_U);
    { const float* g1 = (const float*)A.in[2]; f32x4 gg[4];
#pragma unroll
      for (int j = 0; j < 4; ++j) gg[j] = *(const f32x4*)(g1 + 4 * F.lane + 256 * j);
      for (int m = F.gw; m < NTOK; m += 4 * F.NGW) {
          f32x4 vn[4][4]; const int mn = m + 4 * F.NGW;
          if (mn < NTOK) P0_LOADROWS(vn, mn);
#pragma unroll
          for (int i = 0; i < 4; ++i) { float s = 0.f;
#pragma unroll
              for (int j = 0; j < 4; ++j) s += (v[i][j].x * v[i][j].x + v[i][j].y * v[i][j].y) + (v[i][j].z * v[i][j].z + v[i][j].w * v[i][j].w);
              const float rs = 1.0f / sqrtf(wave_sum(s) * (1.0f / 1024.0f) + EPS); bf16_t* o = U + (size_t)(m + i * F.NGW) * DM;
#pragma unroll
              for (int j = 0; j < 4; ++j) { const f32x4 y = v[i][j] * rs * gg[j]; *(u32x2*)(o + 4 * F.lane + 256 * j) = (u32x2){cvtpk(y.x, y.y), cvtpk(y.z, y.w)}; } }
          if (mn < NTOK) {
#pragma unroll
              for (int i = 0; i < 4; ++i)
#pragma unroll
                  for (int j = 0; j < 4; ++j) v[i][j] = vn[i][j]; } } }
#undef P0_LOADROWS
}
#define LSWZ(row, c16) ((row) * 256 + ((((c16) * 16)) ^ (((row) & 7) << 4)))
__device__ __forceinline__ void px_lru(Frame& F, const Args& A) {
    unsigned char* ws = F.ws; char* lds = (char*)F.lds;
    constexpr int OFF_W = 0, OFF_A = 65536, OFF_AGG = L_LG;
    const int tid = F.tid, lane = F.lane, r32 = lane & 31, hi = lane >> 5, wr = F.wave >> 1, wc = F.wave & 1;
    const int j = F.vcu & 7, Tb = F.vcu >> 3, nun = (256 - Tb + (F.G / 8) - 1) / (F.G / 8);
    const bf16_t* XR = (const bf16_t*)(ws + WS_XR); unsigned short* LOGA = (unsigned short*)(ws + WS_LOGA); unsigned short* BIN = (unsigned short*)(ws + WS_BIN);
    f32x4* SUMM = (f32x4*)(ws + WS_SUMM);
    { const bf16_t* WG2 = (const bf16_t*)(ws + WS_WGATE) + (size_t)j * 256 * 128;
      for (int i = tid; i < 256 * 16; i += 512) { const int n = i >> 4, c = i & 15; *(u32x4*)(lds + OFF_W + LSWZ(n, c)) = *(const u32x4*)(WG2 + n * 128 + c * 8); } }
    const int cg = tid & 15, rg = tid >> 4, ch0 = j * 128 + cg * 8;
    float cwt[4][8], cbs[8];
    { const float* cw = (const float*)A.in[4]; const float* cb = (const float*)A.in[5];
#pragma unroll
      for (int k = 0; k < 4; ++k) { const f32x4 a = *(const f32x4*)(cw + k * 1024 + ch0), b = *(const f32x4*)(cw + k * 1024 + ch0 + 4);
          cwt[k][0] = a.x; cwt[k][1] = a.y; cwt[k][2] = a.z; cwt[k][3] = a.w; cwt[k][4] = b.x; cwt[k][5] = b.y; cwt[k][6] = b.z; cwt[k][7] = b.w; }
      const f32x4 a = *(const f32x4*)(cb + ch0), b = *(const f32x4*)(cb + ch0 + 4); cbs[0] = a.x; cbs[1] = a.y; cbs[2] = a.z; cbs[3] = a.w; cbs[4] = b.x; cbs[5] = b.y; cbs[6] = b.z; cbs[7] = b.w; }
    float gba[2], gbx[2], gc8[2];
#pragma unroll
    for (int p = 0; p < 2; ++p) { const int ch = j * 128 + 64 * wc + 32 * p + r32; gba[p] = ((const float*)A.in[7])[ch]; gbx[p] = ((const float*)A.in[9])[ch]; gc8[p] = ((const float*)(ws + WS_C8))[ch]; }
    u32x4 raw[7], nraw[7];
#define PX_LOAD(dst, T_) do { const int t0_ = (T_) * 128 + 4 * rg; const bool has_ = (rg != 0) || (((T_) & 63) != 0);     \
        _Pragma("unroll") for (int k = 0; k < 7; ++k) dst[k] = (k >= 3 || has_) ? *(const u32x4*)(XR + (size_t)(t0_ - 3 + k) * 1024 + ch0) : (u32x4){0u, 0u, 0u, 0u}; } while (0)
    if (nun > 0) PX_LOAD(raw, Tb);
    for (int ui = 0; ui < nun; ++ui) {
        const int T = Tb + (F.G / 8) * ui;
        {
            f32x4 x0[7], x1[7];
#pragma unroll
            for (int k = 0; k < 7; ++k) unpack8(raw[k], x0[k], x1[k]);
#pragma unroll
            for (int t = 0; t < 4; ++t) { f32x4 y0, y1;
#pragma unroll
                for (int q = 0; q < 4; ++q) { y0[q] = cbs[q] + cwt[0][q] * x0[t][q] + cwt[1][q] * x0[t + 1][q] + cwt[2][q] * x0[t + 2][q] + cwt[3][q] * x0[t + 3][q];
                                              y1[q] = cbs[4 + q] + cwt[0][4 + q] * x1[t][q] + cwt[1][4 + q] * x1[t + 1][q] + cwt[2][4 + q] * x1[t + 2][q] + cwt[3][4 + q] * x1[t + 3][q]; }
                *(u32x4*)(lds + OFF_A + LSWZ(4 * rg + t, cg)) = pack8(y0, y1); }
        }
        __syncthreads();
        if (ui + 1 < nun) PX_LOAD(nraw, T + (F.G / 8));
        bf16x8 af[8];
#pragma unroll
        for (int ks = 0; ks < 8; ++ks) af[ks] = *(const bf16x8*)(lds + OFF_A + LSWZ(32 * wr + r32, 2 * ks + hi));
#pragma unroll
        for (int p = 0; p < 2; ++p) {
            f32x16 aR = {}, aI = {};
            const int nl = 64 * wc + 32 * p + r32;
#pragma unroll
            for (int ks = 0; ks < 8; ++ks) { const bf16x8 bR = *(const bf16x8*)(lds + OFF_W + LSWZ(nl, 2 * ks + hi)), bI = *(const bf16x8*)(lds + OFF_W + LSWZ(128 + nl, 2 * ks + hi));
                aR = __builtin_amdgcn_mfma_f32_32x32x16_bf16(af[ks], bR, aR, 0, 0, 0); aI = __builtin_amdgcn_mfma_f32_32x32x16_bf16(af[ks], bI, aI, 0, 0, 0); }
            float la[16], bb[16], av[16];
#pragma unroll
            for (int r = 0; r < 16; ++r) { const int row = 32 * wr + (r & 3) + 8 * (r >> 2) + 4 * hi;
                const float xv = __uint_as_float((unsigned)(*(const unsigned short*)(lds + OFF_A + LSWZ(row, nl >> 3) + (nl & 7) * 2)) << 16);
                const float rgt = sigmoidf_(aR[r] + gba[p]), igt = sigmoidf_(aI[r] + gbx[p]);
                const float l = (float)(_Float16)(-gc8[p] * rgt);
                const float a = __builtin_amdgcn_exp2f(1.4426950408889634f * l);
                la[r] = l; av[r] = a; bb[r] = xv * igt * __builtin_amdgcn_sqrtf((1.0f - a) * (1.0f + a)); }
            { const size_t base = (((size_t)T * 16 + 4 * wr) * 1024 + (size_t)(j * 128 + nl)) * 8 + 4 * hi;
#pragma unroll
              for (int s = 0; s < 4; ++s) { *(u32x2*)(LOGA + base + (size_t)s * 8192) = (u32x2){cvtpk_h(la[4 * s], la[4 * s + 1]), cvtpk_h(la[4 * s + 2], la[4 * s + 3])};
                                            *(u32x2*)(BIN + base + (size_t)s * 8192) = (u32x2){cvtpk(bb[4 * s], bb[4 * s + 1]), cvtpk(bb[4 * s + 2], bb[4 * s + 3])}; } }
            float sl[4], hs[4];
#pragma unroll
            for (int s = 0; s < 4; ++s) { sl[s] = (av[4 * s] * av[4 * s + 1]) * (av[4 * s + 2] * av[4 * s + 3]);
                hs[s] = ((bb[4 * s] * av[4 * s + 1] + bb[4 * s + 1]) * av[4 * s + 2] + bb[4 * s + 2]) * av[4 * s + 3] + bb[4 * s + 3]; }
            float SL = 1.f, H = 0.f;
#pragma unroll
            for (int s = 0; s < 4; ++s) { const float osl = __shfl_xor(sl[s], 32), ohs = __shfl_xor(hs[s], 32);
                const float sl_a = hi ? osl : sl[s], hs_a = hi ? ohs : hs[s], sl_b = hi ? sl[s] : osl, hs_b = hi ? hs[s] : ohs;
                H = H * sl_a + hs_a; SL *= sl_a; H = H * sl_b + hs_b; SL *= sl_b; }
            if (hi == 0) *(f32x2_t*)(lds + OFF_AGG + (wr * 128 + nl) * 8) = (f32x2_t){SL, H};
        }
        __syncthreads();
        if (tid < 64) { float s0 = 1.f, h0 = 0.f, s1 = 1.f, h1 = 0.f;
#pragma unroll
            for (int w = 0; w < 4; ++w) { const f32x4 g = *(const f32x4*)(lds + OFF_AGG + (w * 128 + 2 * tid) * 8); h0 = h0 * g.x + g.y; s0 *= g.x; h1 = h1 * g.z + g.w; s1 *= g.z; }
            SUMM[(size_t)T * 512 + j * 64 + tid] = (f32x4){s0, h0, s1, h1}; }
#pragma unroll
        for (int k = 0; k < 7; ++k) raw[k] = nraw[k];
    }
#undef PX_LOAD
#ifdef PROBE_PX
    STAMPX(F, 4);
#endif
    { const f32x4 gq = *(const f32x4*)((const float*)A.in[12] + 4 * F.lane), gk = *(const f32x4*)((const float*)A.in[14] + 4 * F.lane);
      for (int tok0 = F.gw; tok0 < NTOK; tok0 += 4 * F.NGW) { u32x2 wq[4], wk[4];
unsigned short wp[4];
#pragma unroll
        for (int i = 0; i < 4; ++i) { const size_t tok = (size_t)tok0 + (size_t)i * F.NGW; wq[i] = *(const u32x2*)((const bf16_t*)(ws + WS_CQ) + tok * 256 + 4 * F.lane); wk[i] = *(const u32x2*)((const bf16_t*)(ws + WS_CKV) + tok * 256 + 4 * F.lane); wp[i] = ((const bf16_t*)(ws + WS_KPE))[tok * ROPE + F.lane]; }
#pragma unroll
        for (int i = 0; i < 4; ++i) { const size_t tok = (size_t)tok0 + (size_t)i * F.NGW;
            { const float a = bflo(wq[i].x), b = bfhi(wq[i].x), c = bflo(wq[i].y), d = bfhi(wq[i].y); const float rs = 1.0f / sqrtf(wave_sum(a * a + b * b + c * c + d * d) * (1.0f / 256.0f) + EPS);
              *(u32x2*)((bf16_t*)(ws + WS_CQN) + tok * 256 + 4 * F.lane) = (u32x2){cvtpk(a * rs * gq.x, b * rs * gq.y), cvtpk(c * rs * gq.z, d * rs * gq.w)}; }
            { const float a = bflo(wk[i].x), b = bfhi(wk[i].x), c = bflo(wk[i].y), d = bfhi(wk[i].y); const float rs = 1.0f / sqrtf(wave_sum(a * a + b * b + c * c + d * d) * (1.0f / 256.0f) + EPS);
              *(u32x2*)((bf16_t*)(ws + WS_CKVN) + tok * 256 + 4 * F.lane) = (u32x2){cvtpk(a * rs * gk.x, b * rs * gk.y), cvtpk(c * rs * gk.z, d * rs * gk.w)}; }
            { const float a = __uint_as_float((unsigned)wp[i] << 16); const float s = wave_sum(a * a); if (F.lane == 0) ((float*)(ws + WS_KPESS))[tok] = s; } } } }
}
#undef LSWZ

__device__ __forceinline__ void py_scan(Frame& F) {
    unsigned char* ws = F.ws;
    const unsigned short* LOGA = (const unsigned short*)(ws + WS_LOGA); const unsigned short* BIN = (const unsigned short*)(ws + WS_BIN);
    const unsigned* GY = (const unsigned*)(ws + WS_GY); unsigned* Z = (unsigned*)(ws + WS_Z); const f32x4* SUMM = (const f32x4*)(ws + WS_SUMM);
    for (int u = F.vcu; u < NB * 64; u += F.G) {
        const int c = u & 63; float h0 = 0.f, h1 = 0.f;
        const size_t cb = ((size_t)u * 16 * 1024 + 2 * F.tid) * 8, zb = (size_t)u * 128 * 512 + F.tid;
        u32x4 la0[2][2], la1[2][2], b0[2][2], b1[2][2]; unsigned gg[2][16];
#define PY_LOAD(s_, t0_) do { _Pragma("unroll") for (int q = 0; q < 2; ++q) { const size_t go = cb + (size_t)(((t0_) >> 3) + q) * 8192; \
            la0[s_][q] = __builtin_nontemporal_load((const u32x4*)(LOGA + go)); la1[s_][q] = __builtin_nontemporal_load((const u32x4*)(LOGA + go + 8)); \
            b0[s_][q] = __builtin_nontemporal_load((const u32x4*)(BIN + go)); b1[s_][q] = __builtin_nontemporal_load((const u32x4*)(BIN + go + 8)); } \
            _Pragma("unroll") for (int i = 0; i < 16; ++i) gg[s_][i] = __builtin_nontemporal_load(GY + zb + (size_t)((t0_) + i) * 512); } while (0)
#define PY_STEP(s_, t0_) do { unsigned zz[16]; \
            _Pragma("unroll") for (int i = 0; i < 16; ++i) { const int q = i >> 3, e2 = (i & 7) >> 1; const unsigned wl0 = la0[s_][q][e2], wl1 = la1[s_][q][e2], wb0 = b0[s_][q][e2], wb1 = b1[s_][q][e2]; \
                const float l0 = (i & 1) ? hhi(wl0) : hlo(wl0), l1 = (i & 1) ? hhi(wl1) : hlo(wl1), x0 = (i & 1) ? bfhi(wb0) : bflo(wb0), x1 = (i & 1) ? bfhi(wb1) : bflo(wb1); \
                h0 = __builtin_amdgcn_exp2f(1.4426950408889634f * l0) * h0 + x0; h1 = __builtin_amdgcn_exp2f(1.4426950408889634f * l1) * h1 + x1; zz[i] = cvtpk(h0 * bflo(gg[s_][i]), h1 * bfhi(gg[s_][i])); } \
            _Pragma("unroll") for (int i = 0; i < 16; ++i) Z[zb + (size_t)((t0_) + i) * 512] = zz[i]; } while (0)
        PY_LOAD(0, 0);
        { int k = u - c;
          for (; k + 8 <= u; k += 8) { f32x4 s[8];
#pragma unroll
              for (int j = 0; j < 8; ++j) s[j] = SUMM[(size_t)(k + j) * 512 + F.tid];
#pragma unroll
              for (int j = 0; j < 8; ++j) { h0 = s[j].x * h0 + s[j].y; h1 = s[j].z * h1 + s[j].w; } }
          for (; k < u; ++k) { const f32x4 s = SUMM[(size_t)k * 512 + F.tid]; h0 = s.x * h0 + s.y; h1 = s.z * h1 + s.w; } }
#pragma unroll 1
        for (int t0 = 0; t0 < 128; t0 += 32) {
            PY_LOAD(1, t0 + 16); PY_STEP(0, t0);
            if (t0 + 32 < 128) PY_LOAD(0, t0 + 32);
            PY_STEP(1, t0 + 16); }
#undef PY_LOAD
#undef PY_STEP
    }
}

struct P7Raw { u32x4 kp; f32x4 c0, c1, s0, s1; float rs; };
__device__ __forceinline__ void p7_load(P7Raw& R, int tok, int h, int c, const float* RSK, const bf16_t* KPE, const float* CS) {
    R.kp = *(const u32x4*)(KPE + (size_t)tok * ROPE + 8 * c); R.rs = RSK[(size_t)tok * 8 + h];
    const float* cs = CS + (size_t)tok * 64 + (c & 3) * 8;
    R.c0 = *(const f32x4*)cs; R.c1 = *(const f32x4*)(cs + 4); R.s0 = *(const f32x4*)(cs + 32); R.s1 = *(const f32x4*)(cs + 36);
}
__device__ __forceinline__ void p7_head(const P7Raw& R, const f32x4 (&gr)[2], int c, u32x4& orr) {
    f32x4 r[2]; unpack8(R.kp, r[0], r[1]);
#pragma unroll
    for (int q = 0; q < 2; ++q) r[q] = r[q] * R.rs * gr[q];
    f32x4 y[2]; const f32x4 cc[2] = {R.c0, R.c1}, sn[2] = {R.s0, R.s1};
#pragma unroll
    for (int q = 0; q < 2; ++q)
#pragma unroll
        for (int j = 0; j < 4; ++j) { const float o = __shfl_xor(r[q][j], 4); y[q][j] = (c < 4) ? r[q][j] * cc[q][j] - o * sn[q][j] : r[q][j] * cc[q][j] + o * sn[q][j]; }
    orr = pack8(y[0], y[1]);
}
__device__ __forceinline__ void p7_item(Frame& F, const Args& A, int pm, int h) {
    unsigned char* ws = F.ws; const int l = F.lane, c = l & 7;
    bf16_t* KR = (bf16_t*)(ws + WS_KR); const bf16_t* KPE = (const bf16_t*)(ws + WS_KPE); const float* CS = (const float*)((const unsigned char*)F.out + OUT_CS); const float* RSK = (const float*)(ws + WS_RSK);
    const float* kg = (const float*)A.in[17];
    f32x4 kgr[2];
#pragma unroll
    for (int q = 0; q < 2; ++q) kgr[q] = *(const f32x4*)(kg + NOPE + 8 * c + 4 * q);
    P7Raw R[4];
#pragma unroll
    for (int t = 0; t < 4; ++t) p7_load(R[t], pm * 256 + F.wave * 32 + t * 8 + (l >> 3), h, c, RSK, KPE, CS);
#pragma unroll
    for (int t = 0; t < 4; ++t) { const int tok = pm * 256 + F.wave * 32 + t * 8 + (l >> 3); u32x4 o2;
        p7_head(R[t], kgr, c, o2);
        *(u32x4*)(KR + ((size_t)tok * NH + h) * ROPE + 8 * c) = o2; }
}

__device__ __forceinline__ void p8_attention(Frame& F, const Args& A) {
    unsigned char* ws = F.ws; const float* qg = (const float*)A.in[16]; const float* CS = (const float*)((const unsigned char*)F.out + OUT_CS);
    const bf16_t* Q = (const bf16_t*)F.out; const bf16_t* KN = (const bf16_t*)(ws + WS_KN); const bf16_t* KR = (const bf16_t*)(ws + WS_KR); const bf16_t* V = (const bf16_t*)(ws + WS_V); bf16_t* O = (bf16_t*)(ws + WS_O);
    for (int it = F.vcu; it < NB * NH * 16; it += F.G) { const int bh = it >> 4, x = it & 15;
        att::attn_block(bh >> 3, bh & 7, 31 - x, Q, KN, KR, V, O, (char*)F.lds, F.lds, qg, CS, F.wave);
        att::attn_block(bh >> 3, bh & 7, x, Q, KN, KR, V, O, (char*)F.lds, F.lds, qg, CS, F.wave); }
}

__device__ __forceinline__ void p12_router(Frame& F, const Args& A) {
    unsigned char* ws = F.ws;
    const bf16_t* H = (const bf16_t*)(ws + WS_MIX);
    const float* br = (const float*)(ws + WS_BR);
    unsigned* cnt = (unsigned*)(ws + WS_CTL); unsigned* rec = (unsigned*)(ws + WS_REC); unsigned* list = (unsigned*)(ws + WS_LIST); float* glist = (float*)(ws + WS_GLIST); float* rsl = (float*)(ws + WS_RSL);
    const bf16_t* WrH = (const bf16_t*)(ws + WS_WR); const bf16_t* WrL = WrH + 96 * 1024;
    char* ldsc = (char*)F.lds;
    constexpr int WP = 528, WLO = 72 * WP;
    constexpr int L_PART = 0, L_LOG = 53248, L_RS = L_LOG + 128 * 76 * 4;
    const int rowB = F.lane & 31, hhB = F.lane >> 5, mt = F.wave & 3, kh = F.wave >> 2;
#define P12_BAR() do { asm volatile("s_waitcnt lgkmcnt(0)" ::: "memory"); __builtin_amdgcn_s_barrier(); asm volatile("" ::: "memory"); } while (0)
    for (int blk = F.vcu; blk < NTOK / 128; blk += F.G) {
        const int T0 = blk * 128;
        const bf16_t* hb = H + (size_t)(T0 + 32 * mt + rowB) * DM + kh * 128 + hhB * 64;
        u32x4 wreg[9]; bf16x8 av[2][8];
#define P12_WLOAD(ch_) do { _Pragma("unroll") for (int i_ = 0; i_ < 9; ++i_) { const int idx_ = F.tid + 512 * i_, wh_ = idx_ >= 2304, rem_ = idx_ - 2304 * wh_, row_ = rem_ >> 5, seg_ = rem_ & 31; \
            wreg[i_] = *(const u32x4*)((wh_ ? WrL : WrH) + (size_t)row_ * 1024 + (ch_) * 256 + seg_ * 8); } } while (0)
#define P12_WSTORE() do { _Pragma("unroll") for (int i_ = 0; i_ < 9; ++i_) { const int idx_ = F.tid + 512 * i_, wh_ = idx_ >= 2304, rem_ = idx_ - 2304 * wh_, row_ = rem_ >> 5, seg_ = rem_ & 31; \
            *(u32x4*)(ldsc + wh_ * WLO + row_ * WP + seg_ * 16) = wreg[i_]; } } while (0)
#define P12_ALOAD(buf_, ch_) do { _Pragma("unroll") for (int s_ = 0; s_ < 8; ++s_) av[buf_][s_] = *(const bf16x8*)(hb + (ch_) * 256 + 8 * s_); } while (0)
        P12_WLOAD(0); P12_ALOAD(0, 0);
        P12_BAR();
        P12_WSTORE();
        f32x16 a0 = {}, a1 = {}, a2 = {}; float ss = 0.f;
        const int bo0 = rowB * WP + (kh * 128 + hhB * 64) * 2, bo2 = (64 + (rowB & 7)) * WP + (kh * 128 + hhB * 64) * 2;
#define P12_CHUNK(cur_, ch_) do { \
        P12_BAR(); \
        if ((ch_) < 3) { P12_WLOAD((ch_) + 1); P12_ALOAD(1 - (cur_), (ch_) + 1); } \
        _Pragma("unroll") for (int s_ = 0; s_ < 8; ++s_) { const bf16x8 ah = av[cur_][s_]; \
            { const u32x4 aw = __builtin_bit_cast(u32x4, ah); ss += (bflo(aw.x) * bflo(aw.x) + bfhi(aw.x) * bfhi(aw.x)) + (bflo(aw.y) * bflo(aw.y) + bfhi(aw.y) * bfhi(aw.y)) + (bflo(aw.z) * bflo(aw.z) + bfhi(aw.z) * bfhi(aw.z)) + (bflo(aw.w) * bflo(aw.w) + bfhi(aw.w) * bfhi(aw.w)); } \
            const bf16x8 h0 = *(const bf16x8*)(ldsc + bo0 + 16 * s_), h1 = *(const bf16x8*)(ldsc + bo0 + 32 * WP + 16 * s_), h2 = *(const bf16x8*)(ldsc + bo2 + 16 * s_); \
            const bf16x8 l0 = *(const bf16x8*)(ldsc + WLO + bo0 + 16 * s_), l1 = *(const bf16x8*)(ldsc + WLO + bo0 + 32 * WP + 16 * s_), l2 = *(const bf16x8*)(ldsc + WLO + bo2 + 16 * s_); \
            a0 = __builtin_amdgcn_mfma_f32_32x32x16_bf16(ah, h0, a0, 0, 0, 0); a1 = __builtin_amdgcn_mfma_f32_32x32x16_bf16(ah, h1, a1, 0, 0, 0); a2 = __builtin_amdgcn_mfma_f32_32x32x16_bf16(ah, h2, a2, 0, 0, 0); \
            a0 = __builtin_amdgcn_mfma_f32_32x32x16_bf16(ah, l0, a0, 0, 0, 0); a1 = __builtin_amdgcn_mfma_f32_32x32x16_bf16(ah, l1, a1, 0, 0, 0); a2 = __builtin_amdgcn_mfma_f32_32x32x16_bf16(ah, l2, a2, 0, 0, 0); } \
        P12_BAR(); \
        if ((ch_) < 3) P12_WSTORE(); } while (0)
        P12_CHUNK(0, 0); P12_CHUNK(1, 1); P12_CHUNK(0, 2); P12_CHUNK(1, 3);
#undef P12_CHUNK
#undef P12_ALOAD
#undef P12_WSTORE
#undef P12_WLOAD
        ss += __shfl_xor(ss, 32);
        LAS float* part = (LAS float*)(F.lds + L_PART) + mt * (49 * 64) + F.lane;
        if (kh == 1) {
#pragma unroll
            for (int r = 0; r < 16; ++r) { part[r * 64] = a0[r]; part[(16 + r) * 64] = a1[r]; part[(32 + r) * 64] = a2[r]; }
            part[48 * 64] = ss; }
        P12_BAR();
        if (kh == 0) { LAS float* lgp = (LAS float*)(F.lds + L_LOG);
#pragma unroll
            for (int r = 0; r < 16; ++r) { const int tk = 32 * mt + (r & 3) + 8 * (r >> 2) + 4 * hhB;
                lgp[tk * 76 + rowB] = a0[r] + part[r * 64]; lgp[tk * 76 + 32 + rowB] = a1[r] + part[(16 + r) * 64];
                if (rowB < 8) lgp[tk * 76 + 64 + rowB] = a2[r] + part[(32 + r) * 64]; }
            if (hhB == 0) ((LAS float*)(F.lds + L_RS))[32 * mt + rowB] = 1.0f / sqrtf((ss + part[48 * 64]) * (1.0f / 1024.0f) + EPS); }
        P12_BAR();
        if (F.tid < 128) { const int tok = T0 + F.tid; const LAS float* l = (const LAS float*)(F.lds + L_LOG) + F.tid * 76; const float rs = ((const LAS float*)(F.lds + L_RS))[F.tid];
            float lv[72];
#pragma unroll
            for (int i = 0; i < 18; ++i) { const f32x4 x4 = *(const LAS f32x4*)(l + 4 * i); lv[4 * i] = rs * x4.x + br[4 * i]; lv[4 * i + 1] = rs * x4.y + br[4 * i + 1]; lv[4 * i + 2] = rs * x4.z + br[4 * i + 2]; lv[4 * i + 3] = rs * x4.w + br[4 * i + 3]; }
            int gs = 0; float gm = lv[0];
#pragma unroll
            for (int i = 1; i < 8; ++i) { if (lv[i] > gm) { gm = lv[i]; gs = i; } }
            float gsum = 0.f;
#pragma unroll
            for (int i = 0; i < 8; ++i) gsum += expf(lv[i] - gm);
            const float gp = 1.0f / gsum;
            float ev[8];
#pragma unroll
            for (int i = 0; i < 8; ++i) { float x = lv[8 + i];
#pragma unroll
                for (int g = 1; g < 8; ++g) x = (gs == g) ? lv[8 + 8 * g + i] : x;
                ev[i] = x; }
            int i0 = 0; float e0 = ev[0];
#pragma unroll
            for (int i = 1; i < 8; ++i) { if (ev[i] > e0) { e0 = ev[i]; i0 = i; } }
            int i1 = -1; float e1 = -__builtin_inff();
#pragma unroll
            for (int i = 0; i < 8; ++i) { if (i != i0 && ev[i] > e1) { e1 = ev[i]; i1 = i; } }
            const float x1 = expf(e1 - e0), den = 1.0f / (1.0f + x1); const float gate0 = gp * den, gate1 = gp * x1 * den;
            const int ex0 = gs * 8 + i0, ex1 = gs * 8 + i1;
            const unsigned r0 = atomicAdd(cnt + ex0 * 16, 1u), r1 = atomicAdd(cnt + ex1 * 16, 1u);
            *(u32x4*)(rec + (size_t)tok * 8) = (u32x4){(unsigned)ex0, r0, __float_as_uint(gate0), (unsigned)ex1}; *(u32x2*)(rec + (size_t)tok * 8 + 4) = (u32x2){r1, __float_as_uint(gate1)};
            list[(size_t)ex0 * 32768 + r0] = (unsigned)tok; glist[(size_t)ex0 * 32768 + r0] = gate0; rsl[(size_t)ex0 * 32768 + r0] = rs;
            list[(size_t)ex1 * 32768 + r1] = (unsigned)tok; glist[(size_t)ex1 * 32768 + r1] = gate1; rsl[(size_t)ex1 * 32768 + r1] = rs; }
    }
#undef P12_BAR
}
__device__ __forceinline__ void p12b_experts(Frame& F, const Args& A, int it_lo, int it_hi, int part, int nparts) {
    unsigned char* ws = F.ws;
    LAS float* scr = (LAS float*)(F.lds + F.wave * 16384);
    bf16_t* W13 = (bf16_t*)(ws + WS_W13); bf16_t* W2 = (bf16_t*)(ws + WS_W2);
    __syncthreads();
#define EXP_SRC_DST(it_, src_, ls_, dst_, ld_, gk_) do { const int which_ = (it_) / 8192, q_ = (it_) % 8192, e_ = q_ / 128, r_ = q_ % 128; \
        if (which_ < 2) { const int kb_ = r_ / 8, nb_ = r_ % 8, n0_ = 32 * nb_, t_ = n0_ / 128, jj_ = n0_ % 128; \
            src_ = (const float*)A.in[which_ == 0 ? 25 : 26] + (size_t)e_ * 1024 * 256 + (size_t)(64 * kb_) * 256 + n0_; ls_ = 256; dst_ = W13 + ((size_t)e_ * 512 + t_ * 256 + which_ * 128 + jj_) * 1024 + 64 * kb_; ld_ = 1024; gk_ = g2 + 64 * kb_; } \
        else { const int kb_ = r_ / 32, nb_ = r_ % 32; src_ = (const float*)A.in[27] + (size_t)e_ * 256 * 1024 + (size_t)(64 * kb_) * 1024 + 32 * nb_; ls_ = 1024; dst_ = W2 + ((size_t)e_ * 1024 + 32 * nb_) * 256 + 64 * kb_; ld_ = 256; gk_ = nullptr; } } while (0)
    { float va[32], vb[32]; const float* src; size_t ls; bf16_t* dA; size_t ldA; bf16_t* dB; size_t ldB; const float* gA; const float* gB; int it = it_lo + part * 8 + F.wave; const int step = nparts * 8;
      const float* g2 = (const float*)A.in[20];
      if (it < it_hi) { EXP_SRC_DST(it, src, ls, dA, ldA, gA); tr_load(va, src, ls, F.lane); }
      while (it < it_hi) {
          int itn = it + step; if (itn < it_hi) { EXP_SRC_DST(itn, src, ls, dB, ldB, gB); tr_load(vb, src, ls, F.lane); }
          tr_finish(va, dA, ldA, scr, F.lane, gA); it = itn; if (it >= it_hi) break;
          itn = it + step; if (itn < it_hi) { EXP_SRC_DST(itn, src, ls, dA, ldA, gA); tr_load(va, src, ls, F.lane); }
          tr_finish(vb, dB, ldB, scr, F.lane, gB); it = itn; } }
#undef EXP_SRC_DST
}
__device__ __forceinline__ void moe_tables(Frame& F) {
    LAS int* tile_e = (LAS int*)(F.lds + L_TILE_E); LAS int* pad_start = (LAS int*)(F.lds + L_PADSTART); LAS int* tile_s = (LAS int*)(F.lds + L_TILE_S); LAS int* cnt_e = (LAS int*)(F.lds + L_CNT); LAS int* TT = (LAS int*)(F.lds + L_TT);
    if (F.wave == 0) { const unsigned* cnt = (const unsigned*)(F.ws + WS_CTL);
        const int c = (int)__hip_atomic_load(cnt + F.lane * 16, __ATOMIC_RELAXED, __HIP_MEMORY_SCOPE_AGENT); const int nt = (c + 255) >> 8; int incl = nt;
#pragma unroll
        for (int o = 1; o < 64; o <<= 1) { const int v = __shfl_up(incl, o); if (F.lane >= o) incl += v; }
        const int ts = incl - nt; pad_start[F.lane] = ts * 256; tile_s[F.lane] = ts; cnt_e[F.lane] = c;
        for (int r = 0; r < nt; ++r) tile_e[ts + r] = F.lane;
        if (F.lane == 63) TT[0] = incl; }
    __syncthreads();
}
__device__ __forceinline__ void p16_combine(Frame& F, const Args& A) {
    unsigned char* ws = F.ws; moe_tables(F); const LAS int* pad_start = (const LAS int*)(F.lds + L_PADSTART);
    const unsigned* rec = (const unsigned*)(ws + WS_REC); const bf16_t* YS = (const bf16_t*)(ws + WS_YS); const bf16_t* H = (const bf16_t*)(ws + WS_MIX);
    for (int tok0 = F.gw; tok0 < NTOK; tok0 += 4 * F.NGW) {
        u32x2 pp[4]; u32x2 ya[4][4], yb[4][4], mm[4][4];
#pragma unroll
        for (int j = 0; j < 4; ++j) { const size_t tok = (size_t)tok0 + (size_t)j * F.NGW; const u32x4 ra = *(const u32x4*)(rec + tok * 8); const unsigned r1 = rec[tok * 8 + 4];
            pp[j] = (u32x2){(unsigned)pad_start[ra.x] + ra.y, (unsigned)pad_start[ra.w] + r1}; }
#pragma unroll
        for (int j = 0; j < 4; ++j) { const size_t ro = ((size_t)tok0 + (size_t)j * F.NGW) * DM;
#pragma unroll
            for (int q = 0; q < 4; ++q) { const int c = 4 * F.lane + 256 * q; mm[j][q] = __builtin_nontemporal_load((const u32x2*)(H + ro + c)); ya[j][q] = __builtin_nontemporal_load((const u32x2*)(YS + (size_t)pp[j].x * DM + c)); yb[j][q] = __builtin_nontemporal_load((const u32x2*)(YS + (size_t)pp[j].y * DM + c)); } }
#pragma unroll
        for (int j = 0; j < 4; ++j) { float* orow = F.out + ((size_t)tok0 + (size_t)j * F.NGW) * DM;
#pragma unroll
            for (int q = 0; q < 4; ++q) { const int c = 4 * F.lane + 256 * q; const u32x2 a = ya[j][q], b = yb[j][q], m2 = mm[j][q]; f32x4 h;
                h.x = bflo(m2.x) + (bflo(a.x) + bflo(b.x)); h.y = bfhi(m2.x) + (bfhi(a.x) + bfhi(b.x)); h.z = bflo(m2.y) + (bflo(a.y) + bflo(b.y)); h.w = bfhi(m2.y) + (bfhi(a.y) + bfhi(b.y)); __builtin_nontemporal_store(h, (f32x4*)(orow + c)); } }
    }
}

typedef GAS unsigned gu32;
#define XB_TMO      128
#define XB_XCNT(j)  (256  + 64 * (j))
#define XB_XSUB(j)  (1280 + 64 * (j))
#define XB_XGEN(j)  (2304 + 64 * (j))
#define XB_TOP      3328
#define XB_TOPGEN   3392
#define XCD_BAR_WORDS 3456
#define XB_SPIN_CAP (1u << 18)

__device__ __forceinline__ unsigned xb_ld(unsigned* p)              { return __hip_atomic_load(p, __ATOMIC_RELAXED, __HIP_MEMORY_SCOPE_AGENT); }
__device__ __forceinline__ unsigned xb_add(unsigned* p, unsigned v) { return __hip_atomic_fetch_add(p, v, __ATOMIC_RELAXED, __HIP_MEMORY_SCOPE_AGENT); }
__device__ __forceinline__ unsigned xb_xcc_id() { return (unsigned)__builtin_amdgcn_s_getreg((3 << 11) | 20) & 0xFu; }
#define XB_SPIN(cond, bar) do { unsigned _sp = 0; while (cond) { __builtin_amdgcn_s_sleep(1); \
    if ((++_sp & 255u) == 0u) { if (xb_ld(&(bar)[XB_TMO])) break; if (_sp > XB_SPIN_CAP) { atomicAdd(&(bar)[XB_TMO], 1u); break; } } } } while (0)

struct XcdBarrier {
    unsigned* bar; unsigned x;
    volatile LAS unsigned* st;
};

__device__ __forceinline__ XcdBarrier xcd_barrier_post(unsigned* bar, volatile LAS unsigned* st, bool leader) {
    XcdBarrier b; b.bar = bar; b.x = xb_xcc_id(); b.st = st;
    if (leader) (void)xb_add(&bar[XB_XCNT(b.x)], 1u);
    return b;
}
__device__ __forceinline__ void xcd_barrier_complete(unsigned* bar, unsigned x, unsigned& nloc, unsigned& nx) {
    const unsigned G = gridDim.x * gridDim.y * gridDim.z;
    unsigned sum, cnt, mine, sp = 0u;
    for (;;) {
        sum = 0u; cnt = 0u; mine = 0u;
#pragma unroll
        for (unsigned j = 0; j < 16; ++j) { const unsigned c = xb_ld(&bar[XB_XCNT(j)]); sum += c; cnt += (c > 0u) ? 1u : 0u; mine = (j == x) ? c : mine; }
        if (sum == G) break;
        __builtin_amdgcn_s_sleep(1);
        if ((++sp & 255u) == 0u) { if (xb_ld(&bar[XB_TMO])) break; if (sp > XB_SPIN_CAP) { atomicAdd(&bar[XB_TMO], 1u); break; } }
    }
    nloc = mine > 0u ? mine : 1u; nx = cnt > 0u ? cnt : 1u;
}

__device__ __forceinline__ void xcd_barrier(const XcdBarrier& b, bool leader) {
    asm volatile("s_waitcnt vmcnt(0)" ::: "memory");
    __syncthreads();
    if (leader) {
        unsigned* bar = b.bar;
        __builtin_amdgcn_s_waitcnt(0);
        unsigned nloc = b.st[0], nx = b.st[1];
        if (nloc == 0u) { xcd_barrier_complete(bar, b.x, nloc, nx); b.st[0] = nloc; b.st[1] = nx; }
        const unsigned old = xb_add(&bar[XB_XSUB(b.x)], 1u);
        const unsigned gen = old / nloc;
        if (old + 1u == (gen + 1u) * nloc) {
            __builtin_amdgcn_fence(__ATOMIC_RELEASE, "agent");
            asm volatile("s_waitcnt vmcnt(0)" ::: "memory");
            const unsigned og = xb_add(&bar[XB_TOP], 1u);
            const unsigned tg = og / nx;
            if (og + 1u == (tg + 1u) * nx) xb_add(&bar[XB_TOPGEN], 1u);
            else XB_SPIN(xb_ld(&bar[XB_TOPGEN]) == tg, bar);
            __builtin_amdgcn_fence(__ATOMIC_ACQUIRE, "agent");
            xb_add(&bar[XB_XGEN(b.x)], 1u);
            asm volatile("s_waitcnt vmcnt(0)" ::: "memory");
        } else {
            XB_SPIN(xb_ld(&bar[XB_XGEN(b.x)]) == gen, bar);
            __builtin_amdgcn_fence(__ATOMIC_ACQUIRE, "agent");
            asm volatile("s_waitcnt vmcnt(0)" ::: "memory");
        }
    }
    __syncthreads();
}


#ifndef MK_PER_PHASE
#define MK_PER_PHASE 0
#endif
#ifndef LK_ALIGN
#define LK_ALIGN true
#endif
#ifndef SK_ALIGN
#define SK_ALIGN true
#endif
#ifndef SK_SP2
#define SK_SP2 true
#endif
constexpr int NPHASE = 17;
__global__ void __launch_bounds__(512, 2) hybrid_fwd(Args args) {
    extern __shared__ __attribute__((aligned(16))) unsigned char lds_raw[];
    cg::grid_group grid = cg::this_grid();
    Frame F;
    F.lds = (LAS unsigned char*)lds_raw; F.ws = args.ws; F.out = args.out;
    F.wave = __builtin_amdgcn_readfirstlane((int)threadIdx.x >> 6); F.lane = lane_id_v(); F.tid = F.wave * 64 + F.lane;
#define REFRESH() do { F.lane = lane_id_v(); F.tid = F.wave * 64 + F.lane; } while (0)
    F.G = gridDim.x; { const int bx = blockIdx.x; F.vcu = (F.G % 8 == 0) ? (bx % 8) * (F.G / 8) + bx / 8 : bx; }
    F.gw = F.vcu * 8 + F.wave; F.NGW = F.G * 8;
    unsigned char* ws = args.ws;
    const int lo = args.ph_lo, hi = args.ph_hi;
    if (F.tid < 2) ((LAS unsigned*)(F.lds + L_BARST))[F.tid] = 0u;
    __syncthreads();
    XcdBarrier bar = xcd_barrier_post((unsigned*)(ws + WS_BAR), (volatile LAS unsigned*)(F.lds + L_BARST), F.tid == 0);
#ifdef DBG_ONLY
#define IN(k) ((k) == DBG_ONLY && lo <= (k) && (k) < hi)
#else
#define IN(k) (lo <= (k) && (k) < hi)
#endif
#ifdef PROBE
#define STAMP(k) do { if (blockIdx.x == 0 && F.tid == 0) ((LAS unsigned long long*)(F.lds + L_STAMP))[k] = __builtin_amdgcn_s_memrealtime(); } while (0)
#else
#define STAMP(k) do {} while (0)
#endif
#ifndef USE_CG_SYNC
#define GRID_BAR(k) do { if ((k) == 0 && lo < 0) grid.sync(); REFRESH(); xcd_barrier(bar, F.tid == 0); REFRESH(); } while (0)
#else
#define GRID_BAR(k) do { grid.sync(); REFRESH(); } while (0)
#endif
#if defined(PROBE_P0) || defined(PROBE_PX)
#define SEAM(k) do { if (IN(k) && IN((k) + 1)) GRID_BAR(k); if ((k) + 1 != 3 && (k) + 1 != 4) STAMP((k) + 1); } while (0)
#else
#define SEAM(k) do { if (IN(k) && IN((k) + 1)) GRID_BAR(k); STAMP((k) + 1); } while (0)
#endif
    typedef pg8::GridOrder GO;

    const size_t T2K = 256 * 2048, T512 = 256 * 512;

    STAMP(0);
    if (IN(0)) { p0_prologue(F, args); } SEAM(0);
    if (IN(1)) {
        pg8::Gemm g{(const char*)(ws + WS_U), (const char*)(ws + WS_WIN), 2048u, 2048u, 1024, nullptr, 1 << 20}; GO S; S.init(NTOK / 256, NP1 / 256, F.G, (int)blockIdx.x, T2K, 0, 0, T2K);
        pg8::EpiP1 E{(bf16_t*)(ws + WS_XR), (bf16_t*)(ws + WS_GY), (bf16_t*)(ws + WS_CQ), (bf16_t*)(ws + WS_CKV), (bf16_t*)(ws + WS_KPE), (bf16_t*)(ws + WS_SGA), (bf16_t*)(ws + WS_SGB)};
        pg8::gemm_phase<pg8::EpiP1, GO, LK_ALIGN, true>(F.lds, g, S, E, F.wave);
        { const int nwg = (NTOK / 256) * (NP1 / 256), rem = nwg % F.G;
          if (rem != 0 && (int)blockIdx.x >= rem) { REFRESH(); p1b_rope_table(F, args, (int)blockIdx.x - rem, F.G - rem); p0_copies(F, args, P0_I_IN, P0_NITEMS, ((int)blockIdx.x - rem) * 8 + F.wave, (F.G - rem) * 8); }
          else if (rem == 0) { REFRESH(); p1b_rope_table(F, args, (int)blockIdx.x, F.G); p0_copies(F, args, P0_I_IN, P0_NITEMS, F.gw, F.NGW); } } } SEAM(1);
    if (IN(2)) { px_lru(F, args); } SEAM(2);
#if defined(PROBE_P0) || defined(PROBE_PX)
    STAMP(5);
#else
#ifndef PROBE_P6
    STAMP(4);
#endif
    STAMP(5);
#endif
    if (IN(5)) { py_scan(F); } SEAM(5);
    if (IN(6)) {
        { pg8::Gemm g{(const char*)(ws + WS_CQN), (const char*)(ws + WS_WUQ), 512u, 512u, 256, nullptr, 1 << 20}; GO S; S.init(NTOK / 256, 6, F.G, (int)blockIdx.x, T512, 0, 0, T512);
          pg8::EpiPlain E{(bf16_t*)F.out, NH * QKD}; pg8::gemm_phase<pg8::EpiPlain, GO, SK_ALIGN, SK_SP2>(F.lds, g, S, E, F.wave); }
        { pg8::Gemm g{(const char*)(ws + WS_CKVN), (const char*)(ws + WS_WUKV), 512u, 512u, 256, nullptr, 1 << 20}; GO S; S.init(NTOK / 256, 8, F.G, (int)blockIdx.x, T512, 0, 0, T512);
          pg8::EpiKV E{(bf16_t*)(ws + WS_KN), (bf16_t*)(ws + WS_V), (const float*)args.in[17], (const float*)(ws + WS_KPESS), (float*)(ws + WS_RSK), (LAS float*)(F.lds + L_KVX), (LAS unsigned*)(F.lds + L_KVC)};
          if (F.tid < 2) ((LAS unsigned*)(F.lds + L_KVC))[F.tid] = 0u; __syncthreads(); pg8::gemm_phase<pg8::EpiKV, GO, SK_ALIGN, SK_SP2>(F.lds, g, S, E, F.wave);
#ifdef PROBE_P6
          STAMP(4);
#endif
          asm volatile("s_waitcnt vmcnt(0)" ::: "memory"); __syncthreads();
          REFRESH();
          pg8::Unit u; for (int i = 0; S.next(i, u); ++i) p7_item(F, args, u.pm, u.pn); } }
    STAMP(7);
    do { if (IN(6) && IN(8)) GRID_BAR(7); STAMP(8); } while (0);
    if (IN(8)) { p8_attention(F, args); } SEAM(8);
    STAMP(10);
    if (IN(10)) {
        pg8::Gemm g{(const char*)(ws + WS_Z), (const char*)(ws + WS_WRNN), 2048u, 4096u, 2048, (const char*)(ws + WS_O), 16}; GO S; S.init(NTOK / 256, 4, F.G, (int)blockIdx.x, T2K, 0, 0, (size_t)256 * 4096);
        pg8::EpiMerge E{(const bf16_t*)(ws + WS_SGA), (const bf16_t*)(ws + WS_SGB), (bf16_t*)(ws + WS_MERGED)}; pg8::gemm_phase<pg8::EpiMerge, GO, LK_ALIGN, true>(F.lds, g, S, E, F.wave); } SEAM(10);
    if (IN(11)) {
        pg8::Gemm g{(const char*)(ws + WS_MERGED), (const char*)(ws + WS_WOUT), 2048u, 2048u, 1024, nullptr, 1 << 20}; GO S; S.init(NTOK / 256, 4, F.G, (int)blockIdx.x, T2K, 0, 0, T2K);
        pg8::EpiResH E{(const float*)args.in[0], (bf16_t*)(ws + WS_MIX)}; pg8::gemm_phase<pg8::EpiResH, GO, LK_ALIGN, true>(F.lds, g, S, E, F.wave); } SEAM(11);
    if (IN(12)) {
        int sw_ = (int)(blockIdx.x & 1); asm volatile("" : "+s"(sw_));
#pragma unroll 1
        for (int ph_ = 0; ph_ < 2; ++ph_) { if ((ph_ ^ sw_) == 0) p12_router(F, args); else p12b_experts(F, args, 0, 2 * 8192, F.vcu, F.G); __syncthreads(); } STAMP(13); } do { if (IN(12) && IN(13)) GRID_BAR(12); } while (0);
    STAMP(14);
    if (IN(14)) {
        moe_tables(F); const int TT = *(const LAS int*)(F.lds + L_TT);
        pg8::Gemm g{(const char*)(ws + WS_MIX), (const char*)(ws + WS_W13), 2048u, 2048u, 1024, nullptr, 1 << 20};
        pg8::MoeOrderT<true> S{TT * 2, F.G, (int)blockIdx.x, 2, (const LAS int*)(F.lds + L_TILE_E), (const LAS int*)(F.lds + L_TILE_S), (const LAS int*)(F.lds + L_CNT), (const unsigned*)(ws + WS_LIST), T2K, (size_t)512 * 2048, T2K};
        pg8::EpiUp E{(bf16_t*)(ws + WS_HS), (const float*)(ws + WS_RSL)}; pg8::gemm_phase<pg8::EpiUp, pg8::MoeOrderT<true>, LK_ALIGN, true>(F.lds, g, S, E, F.wave);
        { const int rem = (TT * 2) % F.G; REFRESH();
          if (rem != 0) { if ((int)blockIdx.x >= rem) p12b_experts(F, args, 2 * 8192, 3 * 8192, (int)blockIdx.x - rem, F.G - rem); }
          else p12b_experts(F, args, 2 * 8192, 3 * 8192, (int)blockIdx.x, F.G); } } SEAM(14);
    if (IN(15)) {
        moe_tables(F); const int TT = *(const LAS int*)(F.lds + L_TT);
        pg8::Gemm g{(const char*)(ws + WS_HS), (const char*)(ws + WS_W2), 512u, 512u, 256, nullptr, 1 << 20};
        pg8::MoeOrderT<false> S{TT * 4, F.G, (int)blockIdx.x, 4, (const LAS int*)(F.lds + L_TILE_E), (const LAS int*)(F.lds + L_TILE_S), (const LAS int*)(F.lds + L_CNT), nullptr, T512, (size_t)1024 * 512, T512};
        pg8::EpiDown E{(bf16_t*)(ws + WS_YS), (const float*)(ws + WS_GLIST)}; pg8::gemm_phase<pg8::EpiDown, pg8::MoeOrderT<false>, SK_ALIGN, SK_SP2>(F.lds, g, S, E, F.wave); } SEAM(15);
    if (IN(16)) { p16_combine(F, args); }
#ifdef PROBE_SYNCS
    for (int i_ = 0; i_ < PROBE_SYNCS; ++i_) grid.sync();
#endif
#ifdef PROBE
    {
        grid.sync(); STAMP(17);
        float* pc = (float*)(ws + WS_CTL + 6144);
        if (blockIdx.x == 0 && F.tid == 0) { const LAS unsigned long long* st = (const LAS unsigned long long*)(F.lds + L_STAMP);
            unsigned long long tb = 0, tc = 0;
            for (int k = 0; k < 17; ++k) { const unsigned long long d = st[k + 1] - st[k]; if ((PROBE_MB >> k) & 1) tb += d; if ((PROBE_MC >> k) & 1) tc += d; }
#if defined(PROBE_P12) && PROBE_P12 == 1
            tb = st[3] - st[12]; tc = st[4] - st[3];
#elif defined(PROBE_P12) && PROBE_P12 == 2
            tb = st[5] - st[4]; tc = st[6] - st[5];
#elif defined(PROBE_P12) && PROBE_P12 == 3
            tb = st[13] - st[6]; tc = st[14] - st[13];
#endif
#ifdef PROBE_P6
            tb = 0; tc = st[7] - st[4];
#endif
#ifdef PROBE_PX
            tb = st[4] - st[2]; tc = st[5] - st[4];
#endif
#ifdef PROBE_P0
            tb = st[3] - st[0]; tc = st[1] - st[4];
#endif
            float E = (float)tb * 0.01f * (float)(PROBE_KB) * 1e-6f;
#ifdef PROBE_CONST
            E = (float)(PROBE_CONST);
#endif
            pc[0] = sqrtf(E * 34.75f); pc[1] = (float)tc * (float)(PROBE_KC); }
        grid.sync();
        const float delta = pc[0]; const int gt = F.gw * 64 + F.lane, GT = F.NGW * 64;
        for (int i = gt; i < (1 << 20); i += GT) F.out[(1 << 20) + i] += delta;
        if (blockIdx.x == 0 && F.tid == 0) { const unsigned long long t0 = __builtin_amdgcn_s_memrealtime(), dt = (unsigned long long)pc[1]; while (__builtin_amdgcn_s_memrealtime() - t0 < dt) __builtin_amdgcn_s_sleep(8); }
    }
#endif
#undef IN
#undef SEAM
}

extern "C" void kernel_launch(void* const* d_in, const int* in_sizes, int n_in, void* d_out, int out_size, void* d_ws, size_t ws_size, hipStream_t stream) {
    static int grid = 0;
    if (grid == 0) {
        if (n_in != 28 || in_sizes[0] != NTOK * DM || out_size != NTOK * DM || ws_size < WS_NEED) {
            fprintf(stderr, "kernel_launch: unexpected shapes (n_in %d, in0 %d, out %d, ws %zu); nothing launched\n", n_in, n_in > 0 ? in_sizes[0] : -1, out_size, ws_size); grid = -1; return; }
        int dev = 0, cus = 0, per_cu = 0;
        (void)hipGetDevice(&dev); (void)hipDeviceGetAttribute(&cus, hipDeviceAttributeMultiprocessorCount, dev);
        (void)hipFuncSetAttribute((const void*)hybrid_fwd, hipFuncAttributeMaxDynamicSharedMemorySize, LDS_BYTES);
        (void)hipOccupancyMaxActiveBlocksPerMultiprocessor(&per_cu, (const void*)hybrid_fwd, 512, LDS_BYTES);
        if (per_cu < 1) { fprintf(stderr, "kernel_launch: occupancy query reports %d workgroups per CU\n", per_cu); }
        (void)hipGetLastError();
        grid = cus > 0 ? cus : 256;
    }
    if (grid < 0) return;
    (void)hipMemsetAsync((char*)d_ws + WS_CTL, 0, CTL_ZERO_BYTES, stream);
    Args a{};
    for (int i = 0; i < 28; ++i) a.in[i] = d_in[i];
    a.out = (float*)d_out; a.ws = (unsigned char*)d_ws;
    for (int i = 0; i < 32; ++i) a.invf[i] = (float)pow(10000.0, -(double)(2 * i) / 64.0);
#if MK_PER_PHASE
    for (int p = 0; p < NPHASE; ++p) { a.ph_lo = p; a.ph_hi = p + 1; void* kargs[] = {&a};
        hipError_t e = hipLaunchCooperativeKernel((const void*)hybrid_fwd, dim3(grid), dim3(512), kargs, LDS_BYTES, stream);
        if (e != hipSuccess) { fprintf(stderr, "kernel_launch: launch of phase %d failed: %s\n", p, hipGetErrorString(e)); break; } }
#else
    a.ph_lo = 0; a.ph_hi = NPHASE; void* kargs[] = {&a};
    hipError_t e = hipLaunchCooperativeKernel((const void*)hybrid_fwd, dim3(grid), dim3(512), kargs, LDS_BYTES, stream);
    if (e != hipSuccess) fprintf(stderr, "kernel_launch: cooperative launch failed: %s (grid %d)\n", hipGetErrorString(e), grid);
#endif
}
```

```cpp
#include <hip/hip_runtime.h>
#include <hip/hip_cooperative_groups.h>
#include <cstdio>
#include <cstdint>
#include <cmath>
namespace cg = cooperative_groups;

constexpr int NB = 4, SEQ = 8192, DM = 1024, NTOK = NB * SEQ;
constexpr int NH = 8, QKD = 192, NOPE = 128, ROPE = 64, VD = 128;
constexpr int NE = 64, DE = 256;
constexpr int NP1 = 4864;
constexpr int MPAD = 81920;
constexpr float EPS = 1e-6f;
constexpr float QSCALE = 0.07216878364870322f * 1.4426950408889634f;

#define GAS __attribute__((address_space(1)))
#define LAS __attribute__((address_space(3)))
typedef unsigned short bf16_t;
typedef short bf16x8 __attribute__((ext_vector_type(8)));
typedef short s16x4 __attribute__((ext_vector_type(4)));
typedef float f32x4 __attribute__((ext_vector_type(4)));
typedef float f32x16 __attribute__((ext_vector_type(16)));
typedef unsigned u32x4 __attribute__((ext_vector_type(4)));
typedef unsigned u32x2 __attribute__((ext_vector_type(2)));
typedef float f32x2_t __attribute__((ext_vector_type(2)));
typedef __bf16 bf16x2_t __attribute__((ext_vector_type(2)));
typedef _Float16 f16x2_t __attribute__((ext_vector_type(2)));

__device__ __forceinline__ unsigned cvtpk(float lo, float hi) { f32x2_t v = {lo, hi}; bf16x2_t b = __builtin_convertvector(v, bf16x2_t); return __builtin_bit_cast(unsigned, b); }
__device__ __forceinline__ unsigned cvtpk_h(float lo, float hi) { f16x2_t v = {(_Float16)lo, (_Float16)hi}; return __builtin_bit_cast(unsigned, v); }
__device__ __forceinline__ float bflo(unsigned w) { return __uint_as_float(w << 16); }
__device__ __forceinline__ float bfhi(unsigned w) { return __uint_as_float(w & 0xffff0000u); }
__device__ __forceinline__ float hlo(unsigned w) { f16x2_t v = __builtin_bit_cast(f16x2_t, w); return (float)v[0]; }
__device__ __forceinline__ float hhi(unsigned w) { f16x2_t v = __builtin_bit_cast(f16x2_t, w); return (float)v[1]; }
__device__ __forceinline__ u32x4 pack8(f32x4 a, f32x4 b) { return (u32x4){cvtpk(a[0], a[1]), cvtpk(a[2], a[3]), cvtpk(b[0], b[1]), cvtpk(b[2], b[3])}; }
__device__ __forceinline__ void unpack8(u32x4 w, f32x4& a, f32x4& b) { a = (f32x4){bflo(w.x), bfhi(w.x), bflo(w.y), bfhi(w.y)}; b = (f32x4){bflo(w.z), bfhi(w.z), bflo(w.w), bfhi(w.w)}; }
__device__ __forceinline__ float sigmoidf_(float x) { return __builtin_amdgcn_rcpf(1.0f + __builtin_amdgcn_exp2f(-1.4426950408889634f * x)); }
__device__ __forceinline__ float gelu_tanh(float x) { const float u = 1.5957691216057308f * (x + 0.044715f * x * x * x); return x * __builtin_amdgcn_rcpf(1.0f + __builtin_amdgcn_exp2f(-1.4426950408889634f * u)); }
__device__ __forceinline__ float wave_sum(float v) {
#pragma unroll
    for (int o = 1; o < 64; o <<= 1) v += __shfl_xor(v, o);
    return v;
}
#define LDS_WAIT() asm volatile("s_waitcnt lgkmcnt(0)" ::: "memory")
__device__ __forceinline__ int lane_id_v() { int l; asm volatile("v_mbcnt_lo_u32_b32 %0, -1, 0\n\tv_mbcnt_hi_u32_b32 %0, -1, %0" : "=v"(l)); return l; }

constexpr size_t MiB = 1u << 20;
constexpr size_t WS_CTL = 0, WS_BAR = 16384, CTL_ZERO_BYTES = 32768;
constexpr size_t WS_C8 = 512 * 1024, WS_WR = WS_C8 + 4096, WS_BR = WS_WR + 1024 * 96 * 4;
constexpr size_t WS_WIN = 1 * MiB, WS_WRNN = WS_WIN + (size_t)NP1 * 1024 * 2, WS_WMLA = WS_WRNN + 2 * MiB, WS_WOUT = WS_WMLA + 2 * MiB,
                 WS_WUQ = WS_WOUT + 2 * MiB, WS_WUKV = WS_WUQ + 1 * MiB, WS_WGATE = WS_WUKV + 1 * MiB, WS_WEND = WS_WGATE + 1 * MiB;
constexpr size_t S0 = 20 * MiB, S1 = 84 * MiB, S2 = 148 * MiB, S3 = 212 * MiB, S4 = 276 * MiB, S5 = 340 * MiB, S6 = 404 * MiB, ST = 468 * MiB;
static_assert(WS_WEND <= S0, "weights fit below the slots");
constexpr size_t WS_U = S0, WS_XR = S1, WS_GY = S2, WS_SGA = S3, WS_SGB = S4, WS_XC = S5, WS_CQN = S6, WS_CKVN = S6 + 16 * MiB;
constexpr size_t WS_CQ = ST, WS_CKV = ST + 16 * MiB, WS_KPE = ST + 32 * MiB, WS_SUMM = ST + 36 * MiB, WS_REC = ST + 38 * MiB, WS_TOKPOS = ST + 39 * MiB, WS_GATEPOS = WS_TOKPOS + 512 * 1024;
constexpr size_t WS_KPESS = ST + 41 * MiB, WS_RSK = ST + 42 * MiB;
constexpr size_t OUT_CS = 96 * MiB;
constexpr size_t WS_LOGA = S0, WS_BIN = S5, WS_Z = S1;
constexpr size_t WS_KN = S2, WS_V = S0, WS_KR = S5, WS_O = S6;
constexpr size_t WS_AOUT = S5, WS_MERGED = S0;
constexpr size_t WS_U2 = S1, WS_W13 = S2, WS_W2 = S3, WS_LIST = 60 * MiB, WS_GLIST = 68 * MiB, WS_YS = 244 * MiB, WS_HS = S0, WS_MIX = S6;
constexpr size_t WS_RSL = 76 * MiB;
constexpr size_t WS_LG = S5, WS_RSTOK = S5 + 16 * MiB;
constexpr size_t WS_NEED = 512 * MiB;
static_assert(WS_GATEPOS + (size_t)MPAD * 4 <= WS_NEED && WS_YS + (size_t)MPAD * 2048 <= WS_MIX && WS_HS + (size_t)MPAD * 512 <= WS_LIST && WS_GLIST + 8 * MiB <= WS_RSL && WS_RSL + 8 * MiB <= S1 && WS_W2 + 32 * MiB <= WS_YS, "workspace map");

constexpr int RING_BYTES = 131072;
constexpr int L_TILE_E = RING_BYTES, L_PADSTART = L_TILE_E + 1536, L_TILE_S = L_PADSTART + 256, L_CNT = L_TILE_S + 256, L_TT = RING_BYTES + 2304, L_LG = RING_BYTES + 4096;
constexpr int L_KVX = RING_BYTES + 4096, L_KVC = RING_BYTES + 8192;
constexpr int L_BARST = RING_BYTES + 30720;
constexpr int L_STAMP = RING_BYTES + 30784;
constexpr int LDS_BYTES = 163840;
static_assert(L_LG + 32 * 72 * 4 <= LDS_BYTES, "LDS map");

#ifdef PROBE
#define STAMPX(F, k) do { if (blockIdx.x == 0 && (F).tid == 0) ((LAS unsigned long long*)((F).lds + L_STAMP))[k] = __builtin_amdgcn_s_memrealtime(); } while (0)
#else
#define STAMPX(F, k) do {} while (0)
#endif
struct Args { const void* in[28]; float* out; unsigned char* ws; float invf[32]; int ph_lo, ph_hi; };

struct Frame {
    LAS unsigned char* lds; unsigned char* ws; float* out;
    int tid, lane, wave, vcu, G, gw, NGW;
};
namespace pg8 {
#define PG8_LAS __attribute__((address_space(3)))
typedef unsigned short bf16_t;
typedef short bf16x8 __attribute__((ext_vector_type(8)));
typedef float f32x4 __attribute__((ext_vector_type(4)));
typedef unsigned u32x4 __attribute__((ext_vector_type(4)));
constexpr int BM = 256, BK = 64, HALF = 128, HTB = HALF * BK * 2  , STAGE_BYTES = 8 * HTB, NXCD = 8, WGM = 8;

__host__ __device__ __forceinline__ int lds_byte(int r, int c) { const int st = (r >> 4) * 2 + (c >> 5), rr = r & 15, cc = c & 31, ob = rr * 64 + cc * 2; return st * 1024 + (ob ^ (((ob >> 9) & 1) << 5)); }
__host__ __device__ __forceinline__ void stage_rc(int b, int& R, int& C) { const int st = b / 1024, sb = b % 1024, swz = sb ^ (((sb >> 9) & 1) << 5); R = (st >> 1) * 16 + swz / 64; C = (st & 1) * 32 + (swz % 64) / 2; }
__host__ __device__ __forceinline__ int perm32(int rho) { const int n = rho >> 4, i = rho & 15; return 8 * (i >> 2) + 4 * n + (i & 3); }

struct Unit { int pm, pn, ex; };
struct Gemm { const char* A; const char* B; unsigned lda, ldb; int K; const char* A2; int ksw; };
__device__ __forceinline__ unsigned cvt_pk_bf16(float lo, float hi) { unsigned r; asm volatile("v_cvt_pk_bf16_f32 %0, %1, %2" : "=v"(r) : "v"(lo), "v"(hi)); return r; }
template <class Epi, class Sched, bool ALIGN_EPI = false, bool SP2 = false>
__device__ __forceinline__ void gemm_phase(PG8_LAS unsigned char* lds, const Gemm g, const Sched& S, const Epi& E, int wid_in) {
    const int wid = wid_in, lane = lane_id_v(), tid = wid * 64 + lane, wr = wid >> 2, wc = wid & 3, fr = lane & 15, fq = lane >> 4;
    const int K = g.K, nt = K / BK;
    unsigned voffA[2], voffB[2]; int rowA[2]; unsigned colA[2];
#pragma unroll
    for (int i = 0; i < 2; ++i) { int R, C; stage_rc(tid * 16 + i * 8192, R, C); const int Rb = Epi::PERM ? ((R & ~31) + perm32(R & 31)) : R; rowA[i] = R; colA[i] = (unsigned)C * 2u;
        voffA[i] = (unsigned)R * g.lda + (unsigned)C * 2u; voffB[i] = (unsigned)Rb * g.ldb + (unsigned)C * 2u; }
    unsigned cvA[2][2], nvA[2][2];
    const size_t kstep = (size_t)(BK * 2);
    const size_t hstepA = (size_t)HALF * g.lda, hstepB = (size_t)HALF * g.ldb;
    const unsigned ldsw = (unsigned)wid * 1024u;
    const int aoff = lds_byte(wr * 64 + fr, fq * 8), boff = lds_byte(wc * 32 + fr, fq * 8);
#define PG8_SA(b, h) (((b) * 2 + (h)) * HTB)
#define PG8_SB(b, h) ((4 + (b) * 2 + (h)) * HTB)
#define PG8_STAGE(bufoff, gbase, voff) do { _Pragma("unroll") for (int _i = 0; _i < 2; ++_i) \
        __builtin_amdgcn_global_load_lds((const unsigned*)((const char*)(gbase) + (voff)[_i]), (PG8_LAS unsigned*)(lds + (bufoff) + ldsw + _i * 8192), 16, 0, 0); } while (0)
#define PG8_STAGE_A(bufoff, gbase, half, isn) do { if constexpr (Sched::GATHER) { unsigned v_[2] = {(isn) ? nvA[half][0] : cvA[half][0], (isn) ? nvA[half][1] : cvA[half][1]}; PG8_STAGE(bufoff, gbase, v_); } \
        else { PG8_STAGE(bufoff, (gbase) + (half) * hstepA, voffA); } } while (0)
#define PG8_LDA(dst, b, h) do { _Pragma("unroll") for (int m = 0; m < 4; ++m) _Pragma("unroll") for (int k = 0; k < 2; ++k) dst[m][k] = *(const PG8_LAS bf16x8*)(lds + PG8_SA(b, h) + aoff + m * 2048 + k * 1024); } while (0)
#define PG8_LDB(dst, b, h) do { _Pragma("unroll") for (int n = 0; n < 2; ++n) _Pragma("unroll") for (int k = 0; k < 2; ++k) dst[n][k] = *(const PG8_LAS bf16x8*)(lds + PG8_SB(b, h) + boff + n * 2048 + k * 1024); } while (0)
#define PG8_MMA(ai, bj, At, Bt) do { __builtin_amdgcn_s_setprio(1); _Pragma("unroll") for (int m = 0; m < 4; ++m) _Pragma("unroll") for (int n = 0; n < 2; ++n) _Pragma("unroll") for (int k = 0; k < 2; ++k) \
        acc[ai][bj][m][n] = __builtin_amdgcn_mfma_f32_16x16x32_bf16(Bt[n][k], At[m][k], acc[ai][bj][m][n], 0, 0, 0); __builtin_amdgcn_s_setprio(0); } while (0)
#define PG8_WAIT_V(n) asm volatile("s_waitcnt vmcnt(" #n ")" ::: "memory")
#define PG8_WAIT_L(n) asm volatile("s_waitcnt lgkmcnt(" #n ")" ::: "memory")
#define PG8_BAR __builtin_amdgcn_s_barrier()
#define PG8_SCHED __builtin_amdgcn_sched_barrier(0)
    Unit cur, nxt; int ui = 0;
    if (!S.next(0, cur)) return;
    f32x4 acc[2][2][4][2];
#pragma unroll
    for (int a = 0; a < 2; ++a)
#pragma unroll
        for (int b = 0; b < 2; ++b)
#pragma unroll
            for (int m = 0; m < 4; ++m)
#pragma unroll
                for (int n = 0; n < 2; ++n) acc[a][b][m][n] = (f32x4){0.f, 0.f, 0.f, 0.f};
    bf16x8 At[4][2], B0[2][2], B1[2][2];
    const char* cA = g.A + S.aoff(cur); const char* cB = g.B + S.boff(cur); const char* cA2 = g.A2 + S.aoff(cur);
    if constexpr (Sched::GATHER) { S.gather(cur, rowA, colA, g.lda, cvA);
#pragma unroll
        for (int h_ = 0; h_ < 2; ++h_) { nvA[h_][0] = cvA[h_][0]; nvA[h_][1] = cvA[h_][1]; } }
    S.a_ready(cur);
    if constexpr (SP2) {
        PG8_STAGE(PG8_SB(0, 0), cB, voffB); PG8_STAGE(PG8_SB(0, 1), cB + hstepB, voffB); PG8_STAGE_A(PG8_SA(0, 0), cA, 0, false); PG8_STAGE_A(PG8_SA(0, 1), cA, 1, false);
        if (wr == 1) PG8_BAR;
        PG8_WAIT_V(2); PG8_BAR;
        PG8_STAGE(PG8_SB(1, 0), cB + kstep, voffB); PG8_STAGE_A(PG8_SA(1, 0), cA + kstep, 0, false); PG8_STAGE(PG8_SB(1, 1), cB + hstepB + kstep, voffB);
        PG8_WAIT_V(6); PG8_BAR;
    } else {
        PG8_STAGE(PG8_SB(0, 0), cB, voffB); PG8_STAGE_A(PG8_SA(0, 0), cA, 0, false); PG8_STAGE(PG8_SB(0, 1), cB + hstepB, voffB); PG8_STAGE_A(PG8_SA(0, 1), cA, 1, false);
        if (wr == 1) PG8_BAR;
        PG8_WAIT_V(4); PG8_BAR;
        PG8_STAGE(PG8_SB(1, 0), cB + kstep, voffB); PG8_STAGE_A(PG8_SA(1, 0), cA + kstep, 0, false); PG8_STAGE(PG8_SB(1, 1), cB + hstepB + kstep, voffB);
        PG8_WAIT_V(6); PG8_BAR;
    }
    for (;;) {
        const bool has_next = S.next(ui + 1, nxt);
        if constexpr (Sched::GATHER) { if (has_next) S.gather(nxt, rowA, colA, g.lda, nvA); }
        const char* nA = has_next ? g.A + S.aoff(nxt) : cA; const char* nB = has_next ? g.B + S.boff(nxt) : cB;
#pragma unroll 1
        for (int t = 0; t < nt; t += 2) {
            const bool last = (t == nt - 2);
            if constexpr (Epi::HAS_MID) { if (t == g.ksw) E.mid(acc, cur, wr, wc, fr, fq); }
            const char* a1 = (t + 1 < g.ksw) ? cA + (size_t)(t + 1) * kstep : cA2 + (size_t)(t + 1 - g.ksw) * kstep;
            const char* a2 = last ? nA : ((t + 2 < g.ksw) ? cA + (size_t)(t + 2) * kstep : cA2 + (size_t)(t + 2 - g.ksw) * kstep); const char* b2 = last ? nB : cB + (size_t)(t + 2) * kstep;
            const char* a3 = a2 + kstep; const char* b3 = b2 + kstep;
            if (last && has_next) S.a_ready(nxt);
            if constexpr (SP2) {
            PG8_LDB(B0, 0, 0); PG8_LDB(B1, 0, 1); PG8_SCHED; PG8_LDA(At, 0, 0); PG8_STAGE_A(PG8_SA(1, 1), a1, 1, false);
            PG8_WAIT_V(8); PG8_WAIT_L(0); PG8_BAR; PG8_MMA(0, 0, At, B0); PG8_MMA(0, 1, At, B1); PG8_BAR; PG8_SCHED;
            PG8_LDA(At, 0, 1); PG8_STAGE(PG8_SB(0, 0), b2, voffB); PG8_STAGE(PG8_SB(0, 1), b2 + hstepB, voffB); PG8_STAGE_A(PG8_SA(0, 0), a2, 0, last);
            PG8_WAIT_V(8); PG8_WAIT_L(0); PG8_BAR; PG8_MMA(1, 0, At, B0); PG8_MMA(1, 1, At, B1); PG8_BAR; PG8_SCHED;
            PG8_LDB(B0, 1, 0); PG8_LDB(B1, 1, 1); PG8_SCHED; PG8_LDA(At, 1, 0); PG8_STAGE_A(PG8_SA(0, 1), a2, 1, last);
            PG8_WAIT_V(8); PG8_WAIT_L(0); PG8_BAR; PG8_MMA(0, 0, At, B0); PG8_MMA(0, 1, At, B1); PG8_BAR; PG8_SCHED;
            PG8_LDA(At, 1, 1); PG8_STAGE(PG8_SB(1, 0), b3, voffB); PG8_STAGE(PG8_SB(1, 1), b3 + hstepB, voffB); PG8_STAGE_A(PG8_SA(1, 0), a3, 0, last);
            PG8_WAIT_V(8); PG8_WAIT_L(0); PG8_BAR; PG8_MMA(1, 0, At, B0); PG8_MMA(1, 1, At, B1); PG8_BAR; PG8_SCHED;
            } else {
            PG8_LDB(B0, 0, 0); PG8_SCHED; PG8_LDA(At, 0, 0); PG8_STAGE_A(PG8_SA(1, 1), a1, 1, false);
            PG8_WAIT_L(8); PG8_BAR; PG8_WAIT_L(0); PG8_MMA(0, 0, At, B0); PG8_BAR; PG8_SCHED;
            PG8_LDB(B1, 0, 1); PG8_STAGE(PG8_SB(0, 0), b2, voffB);
            PG8_BAR; PG8_WAIT_L(0); PG8_MMA(0, 1, At, B1); PG8_BAR;
            PG8_LDA(At, 0, 1); PG8_STAGE_A(PG8_SA(0, 0), a2, 0, last);
            PG8_BAR; PG8_WAIT_L(0); PG8_MMA(1, 0, At, B0); PG8_BAR; PG8_SCHED;
            PG8_STAGE(PG8_SB(0, 1), b2 + hstepB, voffB);
            PG8_WAIT_V(6); PG8_BAR; PG8_MMA(1, 1, At, B1); PG8_BAR;
            PG8_LDB(B0, 1, 0); PG8_SCHED; PG8_LDA(At, 1, 0); PG8_STAGE_A(PG8_SA(0, 1), a2, 1, last);
            PG8_WAIT_L(8); PG8_BAR; PG8_WAIT_L(0); PG8_MMA(0, 0, At, B0); PG8_BAR; PG8_SCHED;
            PG8_LDB(B1, 1, 1); PG8_STAGE(PG8_SB(1, 0), b3, voffB);
            PG8_BAR; PG8_WAIT_L(0); PG8_MMA(0, 1, At, B1); PG8_BAR;
            PG8_LDA(At, 1, 1); PG8_STAGE_A(PG8_SA(1, 0), a3, 0, last);
            PG8_BAR; PG8_WAIT_L(0); PG8_MMA(1, 0, At, B0); PG8_BAR; PG8_SCHED;
            PG8_STAGE(PG8_SB(1, 1), b3 + hstepB, voffB);
            PG8_WAIT_V(6); PG8_BAR; PG8_MMA(1, 1, At, B1); PG8_BAR;
            }
        }
        if constexpr (ALIGN_EPI) { if (wr == 0) PG8_BAR; }
        if constexpr (!Epi::AFTER_DRAIN) { E(acc, cur, wr, wc, fr, fq); S.done(cur); }
        if (!has_next) break;
#pragma unroll
        for (int a = 0; a < 2; ++a)
#pragma unroll
            for (int b = 0; b < 2; ++b)
#pragma unroll
                for (int m = 0; m < 4; ++m)
#pragma unroll
                    for (int n = 0; n < 2; ++n) acc[a][b][m][n] = (f32x4){0.f, 0.f, 0.f, 0.f};
        cur = nxt; cA = nA; cB = nB; cA2 = g.A2 + S.aoff(cur); ++ui;
        if constexpr (Sched::GATHER) {
#pragma unroll
            for (int h_ = 0; h_ < 2; ++h_) { cvA[h_][0] = nvA[h_][0]; cvA[h_][1] = nvA[h_][1]; } }
        if constexpr (ALIGN_EPI) { if (wr == 1) PG8_BAR; }
    }
    PG8_WAIT_V(0);
    if constexpr (!ALIGN_EPI) { if (wr == 0) PG8_BAR; }
    PG8_BAR;
    if constexpr (Epi::AFTER_DRAIN) { E.fused(acc, cur, wr, wc, fr, fq, lds, wid, lane); S.done(cur); }
#undef PG8_SA
#undef PG8_SB
#undef PG8_STAGE
#undef PG8_STAGE_A
#undef PG8_LDA
#undef PG8_LDB
#undef PG8_MMA
#undef PG8_WAIT_V
#undef PG8_WAIT_L
#undef PG8_BAR
#undef PG8_SCHED
}
}

namespace pg8 {
struct GridOrder {
    static constexpr bool GATHER = false;
    int nM, nN, nwg, G, c, a_sh; size_t a_sm, a_sn, b_sn; int x03 = 0;
    __device__ __forceinline__ void init(int nM_, int nN_, int G_, int c_, size_t a_sm_, int a_sh_, size_t a_sn_, size_t b_sn_) { nM = nM_; nN = nN_; nwg = nM * nN; G = G_; c = c_; a_sm = a_sm_; a_sh = a_sh_; a_sn = a_sn_; b_sn = b_sn_; }
    __device__ __forceinline__ bool next(int i, Unit& u) const {
        long L = (long)i * G + c;
        if (x03 && i == nwg / G) { if (c & 4) return false; L = (long)i * G + (((c >> 3) << 2) | (c & 3)); }
        if (L >= nwg) return false;
        int wgid = (int)L; { const int q = nwg / NXCD, r = nwg % NXCD, xcd = wgid % NXCD, off = wgid / NXCD; wgid = (xcd < r ? xcd * (q + 1) : r * (q + 1) + (xcd - r) * q) + off; }
        const int nig = WGM * nN, gid = wgid / nig, fm = gid * WGM, gsz = (nM - fm) < WGM ? (nM - fm) : WGM;
        u.pm = fm + ((wgid % nig) % gsz); u.pn = (wgid % nig) / gsz; u.ex = 0; return true;
    }
    __device__ __forceinline__ size_t aoff(const Unit& u) const { return (size_t)u.pm * a_sm + (size_t)(u.pn >> a_sh) * a_sn; }
    __device__ __forceinline__ size_t boff(const Unit& u) const { return (size_t)u.pn * b_sn; }
    __device__ __forceinline__ void a_ready(const Unit&) const {}
    __device__ __forceinline__ void done(const Unit&) const {}
};
template <bool GATHER_>
struct MoeOrderT {
    static constexpr bool GATHER = GATHER_;
    int total, G, c, nsub; const PG8_LAS int* tile_e; const PG8_LAS int* tile_s; const PG8_LAS int* cnt_e; const unsigned* list; size_t a_sm, b_se, b_sn; int xo;
    __device__ __forceinline__ bool next(int i, Unit& u) const {
        int rt, pn;
        if (xo) { const int s = c >> 3, rpx = 32 / nsub; rt = (i * 8 + (c & 7)) * rpx + s / nsub; pn = s % nsub; if (rt * nsub >= total) return false; }
        else { const long L = (long)i * G + c; if (L >= total) return false; rt = (int)L / nsub; pn = (int)L - rt * nsub; }
        const int e = __builtin_amdgcn_readfirstlane(tile_e[rt]), ts = __builtin_amdgcn_readfirstlane(tile_s[e]);
        u.pm = rt; u.pn = pn; u.ex = e | ((rt - ts) << 8); return true;
    }
    __device__ __forceinline__ size_t aoff(const Unit& u) const { return GATHER_ ? (size_t)0 : (size_t)u.pm * a_sm; }
    __device__ __forceinline__ size_t boff(const Unit& u) const { return (size_t)(u.ex & 255) * b_se + (size_t)u.pn * b_sn; }
    __device__ __forceinline__ void gather(const Unit& u, const int (&rowA)[2], const unsigned (&colA)[2], unsigned lda, unsigned (&v)[2][2]) const {
        const int e = u.ex & 255, base = (u.ex >> 8) * 256, n = __builtin_amdgcn_readfirstlane(cnt_e[e]);
#pragma unroll
        for (int h = 0; h < 2; ++h)
#pragma unroll
            for (int i = 0; i < 2; ++i) { const int lr = base + h * 128 + rowA[i]; const unsigned tok = (lr < n) ? list[(size_t)e * 32768 + lr] : 0u; v[h][i] = tok * lda + colA[i]; }
    }
    __device__ __forceinline__ void a_ready(const Unit&) const {}
    __device__ __forceinline__ void done(const Unit&) const {}
};

#define EPI_FOR_AI_M  _Pragma("unroll") for (int ai = 0; ai < 2; ++ai) _Pragma("unroll") for (int m = 0; m < 4; ++m)
#define EPI_ROW (u.pm * BM + ai * HALF + wr * 64 + m * 16 + fr)

struct EpiP1 {
    static constexpr bool PERM = true, AFTER_DRAIN = false, HAS_MID = false;
    bf16_t *XR, *GY, *CQ, *CKV, *KPE, *RAT, *SGB;
    __device__ __forceinline__ void operator()(const f32x4 (&acc)[2][2][4][2], const Unit& u, int wr, int wc, int fr, int fq) const {
        const int pn = u.pn;
        if (pn >= 11) { const int c = (pn - 11) * 128 + wc * 32 + 8 * fq;
            EPI_FOR_AI_M { const size_t off = (size_t)EPI_ROW * 1024 + c; f32x4 r0, r1, s0, s1;
#pragma unroll
                for (int j = 0; j < 4; ++j) { const float ea0 = __builtin_amdgcn_exp2f(-1.4426950408889634f * acc[ai][0][m][0][j]), ea1 = __builtin_amdgcn_exp2f(-1.4426950408889634f * acc[ai][0][m][1][j]);
                    const float eb0 = __builtin_amdgcn_exp2f(-1.4426950408889634f * acc[ai][1][m][0][j]), eb1 = __builtin_amdgcn_exp2f(-1.4426950408889634f * acc[ai][1][m][1][j]);
                    r0[j] = (1.0f + eb0) * __builtin_amdgcn_rcpf(1.0f + ea0); r1[j] = (1.0f + eb1) * __builtin_amdgcn_rcpf(1.0f + ea1); s0[j] = __builtin_amdgcn_rcpf(1.0f + eb0); s1[j] = __builtin_amdgcn_rcpf(1.0f + eb1); }
                *(u32x4*)(RAT + off) = pack8(r0, r1); *(u32x4*)(SGB + off) = pack8(s0, s1); }
            return; }
        bf16_t* base; int ld, colt, act = 0, climit = 256;
        if (pn < 4) { base = XR; ld = 1024; colt = pn * 256; }
        else if (pn < 8) { base = GY; ld = 1024; colt = (pn - 4) * 256; act = 1; }
        else if (pn == 8) { base = CQ; ld = 256; colt = 0; }
        else if (pn == 9) { base = CKV; ld = 256; colt = 0; }
        else { base = KPE; ld = 64; colt = 0; climit = 64; }
        EPI_FOR_AI_M { const size_t row = EPI_ROW;
#pragma unroll
            for (int bj = 0; bj < 2; ++bj) { const int c = bj * HALF + wc * 32 + 8 * fq; f32x4 v0 = acc[ai][bj][m][0], v1 = acc[ai][bj][m][1];
                if (act == 1) { _Pragma("unroll") for (int j = 0; j < 4; ++j) { v0[j] = gelu_tanh(v0[j]); v1[j] = gelu_tanh(v1[j]); } }
                if (c < climit) *(u32x4*)(base + row * ld + colt + c) = pack8(v0, v1); } }
    }
};
struct EpiGates {
    static constexpr bool PERM = true, AFTER_DRAIN = false, HAS_MID = false;
    const bf16_t* XC; const float *ba, *bx, *c8; bf16_t* LOGA; bf16_t* BIN;
    __device__ __forceinline__ void operator()(const f32x4 (&acc)[2][2][4][2], const Unit& u, int wr, int wc, int fr, int fq) const {
        const int ch = u.pn * 128 + wc * 32 + 8 * fq;
#pragma unroll
        for (int n = 0; n < 2; ++n) { const f32x4 br = *(const f32x4*)(ba + ch + 4 * n), bi = *(const f32x4*)(bx + ch + 4 * n), cc = *(const f32x4*)(c8 + ch + 4 * n);
            EPI_FOR_AI_M { const size_t off = (size_t)EPI_ROW * 1024 + ch + 4 * n;
                const u32x2 xw = *(const u32x2*)(XC + off); const f32x4 xv = {bflo(xw.x), bfhi(xw.x), bflo(xw.y), bfhi(xw.y)};
                f32x4 la, bb;
#pragma unroll
                for (int j = 0; j < 4; ++j) { const float r = sigmoidf_(acc[ai][0][m][n][j] + br[j]), ig = sigmoidf_(acc[ai][1][m][n][j] + bi[j]); const float l = -cc[j] * r;
                    const float t = 2.0f * l;
                    const float em = -t * (1.0f + t * (0.5f + t * (0.16666667f + t * (0.041666668f + t * (0.0083333338f + t * 0.0013888889f)))));
                    la[j] = l; bb[j] = xv[j] * ig * __builtin_amdgcn_sqrtf(fmaxf(em, 0.0f)); }
                *(u32x2*)(LOGA + off) = (u32x2){cvtpk_h(la[0], la[1]), cvtpk_h(la[2], la[3])};
                *(u32x2*)(BIN + off) = (u32x2){cvtpk(bb[0], bb[1]), cvtpk(bb[2], bb[3])}; } }
    }
};
struct EpiQ {
    static constexpr bool PERM = true, AFTER_DRAIN = false, HAS_MID = false;
    bf16_t* Q;
    __device__ __forceinline__ void operator()(const f32x4 (&acc)[2][2][4][2], const Unit& u, int wr, int wc, int fr, int fq) const {
        EPI_FOR_AI_M { const size_t row = EPI_ROW;
#pragma unroll
            for (int bj = 0; bj < 2; ++bj) { const int c = bj * HALF + wc * 32 + 8 * fq;
                if (c < QKD) *(u32x4*)(Q + row * (NH * QKD) + u.pn * QKD + c) = pack8(acc[ai][bj][m][0], acc[ai][bj][m][1]); } }
    }
};
struct EpiKV {
    static constexpr bool PERM = true, AFTER_DRAIN = false, HAS_MID = false;
    bf16_t *KN, *V; const float* kg; const float* kpess; float* rsk; PG8_LAS float* xs; PG8_LAS unsigned* cnt;
    __device__ __forceinline__ void operator()(const f32x4 (&acc)[2][2][4][2], const Unit& u, int wr, int wc, int fr, int fq) const {
        PG8_LAS float* xp = xs + wr * 512;
        EPI_FOR_AI_M { const f32x4 a = acc[ai][0][m][0], b = acc[ai][0][m][1]; float s = ((a.x * a.x + a.y * a.y) + (a.z * a.z + a.w * a.w)) + ((b.x * b.x + b.y * b.y) + (b.z * b.z + b.w * b.w));
            s += __shfl_xor(s, 16); s += __shfl_xor(s, 32);
            if (fq == 0) xp[(ai * 64 + m * 16 + fr) * 4 + wc] = s; }
        EPI_FOR_AI_M { const size_t off = (size_t)EPI_ROW * 1024 + u.pn * 128 + wc * 32 + 8 * fq; *(u32x4*)(V + off) = pack8(acc[ai][1][m][0], acc[ai][1][m][1]); }
        asm volatile("s_waitcnt lgkmcnt(0)" ::: "memory");
        unsigned old = 0u; if (fr == 0 && fq == 0) old = __hip_atomic_fetch_add(cnt + wr, 1u, __ATOMIC_RELAXED, __HIP_MEMORY_SCOPE_WORKGROUP);
        const unsigned target = ((unsigned)__builtin_amdgcn_readfirstlane((int)old) / 4u + 1u) * 4u;
        while (__hip_atomic_load(cnt + wr, __ATOMIC_RELAXED, __HIP_MEMORY_SCOPE_WORKGROUP) < target) __builtin_amdgcn_s_sleep(1);
        asm volatile("" ::: "memory");
        const f32x4 g0 = *(const f32x4*)(kg + wc * 32 + 8 * fq), g1 = *(const f32x4*)(kg + wc * 32 + 8 * fq + 4);
        EPI_FOR_AI_M { const size_t row = EPI_ROW; const f32x4 p = *(const PG8_LAS f32x4*)(xp + (ai * 64 + m * 16 + fr) * 4);
            const float rs = 1.0f / sqrtf((((p.x + p.y) + (p.z + p.w)) + kpess[row]) * (1.0f / 192.0f) + EPS);
            *(u32x4*)(KN + row * 1024 + u.pn * 128 + wc * 32 + 8 * fq) = pack8(acc[ai][0][m][0] * rs * g0, acc[ai][0][m][1] * rs * g1);
            if (wc == 0 && fq == 0) rsk[row * 8 + u.pn] = rs; }
    }
};
struct EpiPlain {
    static constexpr bool PERM = true, AFTER_DRAIN = false, HAS_MID = false;
    bf16_t* O; int ldc;
    __device__ __forceinline__ void operator()(const f32x4 (&acc)[2][2][4][2], const Unit& u, int wr, int wc, int fr, int fq) const {
        EPI_FOR_AI_M { const size_t row = EPI_ROW;
#pragma unroll
            for (int bj = 0; bj < 2; ++bj) *(u32x4*)(O + row * ldc + u.pn * BM + bj * HALF + wc * 32 + 8 * fq) = pack8(acc[ai][bj][m][0], acc[ai][bj][m][1]); }
    }
};
struct EpiMerge {
    static constexpr bool PERM = true, AFTER_DRAIN = false, HAS_MID = true;
    const bf16_t *RAT, *SGB; bf16_t* MG;
    __device__ __forceinline__ void mid(f32x4 (&acc)[2][2][4][2], const Unit& u, int wr, int wc, int fr, int fq) const {
        asm volatile("" : "+v"(fr), "+v"(fq));
        EPI_FOR_AI_M { const size_t row = EPI_ROW;
#pragma unroll
            for (int bj = 0; bj < 2; ++bj) { const size_t off = row * 1024 + u.pn * BM + bj * HALF + wc * 32 + 8 * fq;
                f32x4 g0, g1; unpack8(*(const u32x4*)(RAT + off), g0, g1);
                acc[ai][bj][m][0] = acc[ai][bj][m][0] * g0; acc[ai][bj][m][1] = acc[ai][bj][m][1] * g1; }
            if (m == 3) asm volatile("" ::: "memory"); }
    }
    __device__ __forceinline__ void operator()(const f32x4 (&acc)[2][2][4][2], const Unit& u, int wr, int wc, int fr, int fq) const {
        EPI_FOR_AI_M { const size_t row = EPI_ROW;
#pragma unroll
            for (int bj = 0; bj < 2; ++bj) { const size_t off = row * 1024 + u.pn * BM + bj * HALF + wc * 32 + 8 * fq;
                f32x4 s0, s1; unpack8(*(const u32x4*)(SGB + off), s0, s1);
                *(u32x4*)(MG + off) = pack8(s0 * acc[ai][bj][m][0], s1 * acc[ai][bj][m][1]); } }
    }
};
struct EpiResH {
    static constexpr bool PERM = true, AFTER_DRAIN = false, HAS_MID = false;
    const float* X; bf16_t* H;
    __device__ __forceinline__ void operator()(const f32x4 (&acc)[2][2][4][2], const Unit& u, int wr, int wc, int fr, int fq) const {
        EPI_FOR_AI_M { const size_t row = EPI_ROW;
#pragma unroll
            for (int bj = 0; bj < 2; ++bj) { const size_t off = row * 1024 + u.pn * BM + bj * HALF + wc * 32 + 8 * fq;
                const f32x4 x0 = *(const f32x4*)(X + off), x1 = *(const f32x4*)(X + off + 4);
                *(u32x4*)(H + off) = pack8(x0 + acc[ai][bj][m][0], x1 + acc[ai][bj][m][1]); } }
    }
};
struct EpiUp {
    static constexpr bool PERM = true, AFTER_DRAIN = false, HAS_MID = false;
    bf16_t* HS; const float* rsl;
    __device__ __forceinline__ void operator()(const f32x4 (&acc)[2][2][4][2], const Unit& u, int wr, int wc, int fr, int fq) const {
        const float* rp = rsl + (size_t)(u.ex & 255) * 32768 + (u.ex >> 8) * 256;
        EPI_FOR_AI_M { const size_t off = (size_t)EPI_ROW * DE + u.pn * 128 + wc * 32 + 8 * fq; const float rs = rp[ai * HALF + wr * 64 + m * 16 + fr];
            f32x4 h0, h1;
#pragma unroll
            for (int j = 0; j < 4; ++j) { const float a0 = rs * acc[ai][0][m][0][j], a1 = rs * acc[ai][0][m][1][j]; h0[j] = a0 * sigmoidf_(a0) * (rs * acc[ai][1][m][0][j]); h1[j] = a1 * sigmoidf_(a1) * (rs * acc[ai][1][m][1][j]); }
            *(u32x4*)(HS + off) = pack8(h0, h1); }
    }
};
struct EpiDown {
    static constexpr bool PERM = true, AFTER_DRAIN = false, HAS_MID = false;
    bf16_t* YS; const float* glist; const PG8_LAS int* cnt_e;
    __device__ __forceinline__ void operator()(const f32x4 (&acc)[2][2][4][2], const Unit& u, int wr, int wc, int fr, int fq) const {
        const float* gp = glist + (size_t)(u.ex & 255) * 32768 + (u.ex >> 8) * 256;
        const int nrow = cnt_e[u.ex & 255] - (u.ex >> 8) * 256;
        EPI_FOR_AI_M { const size_t row = EPI_ROW; const int lr = ai * HALF + wr * 64 + m * 16 + fr;
            if (lr < nrow) { const float g = gp[lr];
#pragma unroll
                for (int bj = 0; bj < 2; ++bj) *(u32x4*)(YS + row * 1024 + u.pn * BM + bj * HALF + wc * 32 + 8 * fq) = pack8(acc[ai][bj][m][0] * g, acc[ai][bj][m][1] * g); } }
    }
};
#undef EPI_FOR_AI_M
#undef EPI_ROW
}

namespace att {
constexpr int SHM_V = 16384, SHM_KN = 16384, SHM_KR = 8192;
constexpr int OFF_V = 0, OFF_KN = 3 * SHM_V, OFF_KR = OFF_KN + 2 * SHM_KN, OFF_WS = OFF_KR + 2 * SHM_KR, OFF_QR = OFF_WS + 8 * 64 * 4, QR_WAVE = 7168, QPARK = 5, ATT_LDS = OFF_QR + 8 * QR_WAVE;
static_assert(ATT_LDS <= L_BARST, "attention LDS stays below the grid barrier words");
constexpr float THR = 8.0f;
#define KSWZ(row, colB) ((row) * 256 + ((colB) ^ (((row) & 15) << 4)))
#define KRSWZ(row, ch) (((row) >> 1) * 256 + (((((row) & 1) << 3) + (ch)) ^ (((row) >> 1) & 7)) * 16)
#define SBAR() __builtin_amdgcn_sched_barrier(0)
__device__ __forceinline__ int v_st(int k, int c) { const int kk = (k & ~0xC) | ((k & 4) << 1) | ((k & 8) >> 1); return ((kk >> 3) * 4 + (c >> 5)) * 512 + ((kk & 7) * 32 + (c & 31)) * 2; }
__device__ __forceinline__ int v_rd_base(int lane) { return ((lane & 3) << 3) | (((lane >> 2) & 3) << 6) | (((lane >> 4) & 1) << 5) | (((lane >> 5) & 1) << 8); }
constexpr int v_rd_off(int d0, int ks, int half) { return d0 * 512 + ks * 4096 + half * 2048; }
__device__ __forceinline__ int crow(int r, int hi) { return (r & 3) + 8 * (r >> 2) + 4 * hi; }
__device__ __forceinline__ unsigned cvtpk_a(float lo, float hi) { unsigned r; asm volatile("v_cvt_pk_bf16_f32 %0, %1, %2" : "=v"(r) : "v"(lo), "v"(hi)); return r; }

__device__ __forceinline__ void mask_tile(f32x16& p0, f32x16& p1, int dq) {
    const float NEG = -__builtin_inff();
#pragma unroll
    for (int r = 0; r < 16; ++r) {
        const int c = (r & 3) + 8 * (r >> 2);
        if (dq - c < 0) p0[r] = NEG;
        if (dq - c - 32 < 0) p1[r] = NEG;
    }
}
__device__ __forceinline__ void partialSM(f32x16& p0, f32x16& p1, float& m_reg, float& alpha) {
    float pmax = p0[0];
#pragma unroll
    for (int r = 1; r < 16; ++r) pmax = fmaxf(pmax, p0[r]);
#pragma unroll
    for (int r = 0; r < 16; ++r) pmax = fmaxf(pmax, p1[r]);
    { auto rr = __builtin_amdgcn_permlane32_swap(__float_as_uint(pmax), __float_as_uint(pmax), false, false);
      pmax = fmaxf(__uint_as_float(rr[0]), __uint_as_float(rr[1])); }
    float mn;
    if (__builtin_expect(__all((pmax - m_reg) <= THR), 1)) { mn = m_reg; alpha = 1.f; }
    else { mn = fmaxf(m_reg, pmax); alpha = __builtin_amdgcn_exp2f(m_reg - mn); m_reg = mn; }
#pragma unroll
    for (int r = 0; r < 16; ++r) p0[r] = __builtin_amdgcn_exp2f(p0[r] - mn);
#pragma unroll
    for (int r = 0; r < 16; ++r) p1[r] = __builtin_amdgcn_exp2f(p1[r] - mn);
}
__device__ __forceinline__ void partialSM_rel(f32x16& p0, f32x16& p1, float& m_reg, float& alpha) {
    float pmax = p0[0];
#pragma unroll
    for (int r = 1; r < 16; ++r) pmax = fmaxf(pmax, p0[r]);
#pragma unroll
    for (int r = 0; r < 16; ++r) pmax = fmaxf(pmax, p1[r]);
    { auto rr = __builtin_amdgcn_permlane32_swap(__float_as_uint(pmax), __float_as_uint(pmax), false, false);
      pmax = fmaxf(__uint_as_float(rr[0]), __uint_as_float(rr[1])); }
    if (__builtin_expect(__all(pmax <= THR), 1)) { alpha = 1.f; }
    else { const float dl = fmaxf(pmax, 0.f); alpha = __builtin_amdgcn_exp2f(-dl); m_reg += dl;
#pragma unroll
        for (int r = 0; r < 16; ++r) { p0[r] -= dl; p1[r] -= dl; } }
#pragma unroll
    for (int r = 0; r < 16; ++r) p0[r] = __builtin_amdgcn_exp2f(p0[r]);
#pragma unroll
    for (int r = 0; r < 16; ++r) p1[r] = __builtin_amdgcn_exp2f(p1[r]);
}
__device__ __forceinline__ void rowmaxSM_rel(f32x16& p0, f32x16& p1, float& m_reg, float& alpha) {
    float ma = p0[0], mb = p0[8], mc = p1[0], md = p1[8];
#pragma unroll
    for (int r = 1; r < 8; ++r) { ma = fmaxf(ma, p0[r]); mb = fmaxf(mb, p0[8 + r]); mc = fmaxf(mc, p1[r]); md = fmaxf(md, p1[8 + r]); }
    float pmax = fmaxf(fmaxf(ma, mb), fmaxf(mc, md));
    { auto rr = __builtin_amdgcn_permlane32_swap(__float_as_uint(pmax), __float_as_uint(pmax), false, false);
      pmax = fmaxf(__uint_as_float(rr[0]), __uint_as_float(rr[1])); }
    if (__builtin_expect(__all(pmax <= THR), 1)) { alpha = 1.f; }
    else { const float dl = fmaxf(pmax, 0.f); alpha = __builtin_amdgcn_exp2f(-dl); m_reg += dl;
#pragma unroll
        for (int r = 0; r < 16; ++r) { p0[r] -= dl; p1[r] -= dl; } }
}
__device__ __forceinline__ void finishSM(f32x16& p0, f32x16& p1, float alpha, float& l_reg, bf16x8& pa0, bf16x8& pa1, bf16x8& pa2, bf16x8& pa3) {
    float ps = 0;
#pragma unroll
    for (int r = 0; r < 16; ++r) ps += p0[r];
#pragma unroll
    for (int r = 0; r < 16; ++r) ps += p1[r];
    { auto rr = __builtin_amdgcn_permlane32_swap(__float_as_uint(ps), __float_as_uint(ps), false, false);
      ps = __uint_as_float(rr[0]) + __uint_as_float(rr[1]); }
    l_reg = l_reg * alpha + ps;
#define PK4(P, B_, OUT) do { unsigned a0 = cvtpk_a(P[B_+0], P[B_+1]), a1 = cvtpk_a(P[B_+2], P[B_+3]);                          \
        unsigned b0 = cvtpk_a(P[B_+4], P[B_+5]), b1 = cvtpk_a(P[B_+6], P[B_+7]);                                             \
        auto r0 = __builtin_amdgcn_permlane32_swap(a0, b0, false, false); auto r1 = __builtin_amdgcn_permlane32_swap(a1, b1, false, false); \
        u32x4 w = {r0[0], r1[0], r0[1], r1[1]}; OUT = *reinterpret_cast<bf16x8*>(&w); } while (0)
    PK4(p0, 0, pa0); PK4(p0, 8, pa1); PK4(p1, 0, pa2); PK4(p1, 8, pa3);
#undef PK4
}
template <int KB>
__device__ __forceinline__ void qkt(f32x16& p0, f32x16& p1, const char* lds, int r32, int hi, const bf16x8* qr, const char* qrl, float c0) {
#pragma unroll
    for (int r = 0; r < 16; ++r) { p0[r] = c0; p1[r] = c0; }
    int sw = (r32 & 15) << 4; asm volatile("" : "+v"(sw));
    const char* kbase = lds + OFF_KN + KB * SHM_KN + r32 * 256; const char* krb[4];
#pragma unroll
    for (int dd = 0; dd < 4; ++dd) krb[dd] = lds + OFF_KR + KB * SHM_KR + KRSWZ(r32, dd * 2 + hi);
#pragma unroll
    for (int d0 = 0; d0 < 8; ++d0) { const char* a = kbase + (((d0 * 16 + hi * 8) * 2) ^ sw);
        bf16x8 b0 = *reinterpret_cast<const bf16x8*>(a);
        bf16x8 b1 = *reinterpret_cast<const bf16x8*>(a + 32 * 256);
        const bf16x8 qf = (d0 < QPARK) ? qr[d0] : *reinterpret_cast<const bf16x8*>(qrl + 4096 + (d0 - QPARK) * 1024 + (r32 + 32 * hi) * 16);
        p0 = __builtin_amdgcn_mfma_f32_32x32x16_bf16(b0, qf, p0, 0, 0, 0);
        p1 = __builtin_amdgcn_mfma_f32_32x32x16_bf16(b1, qf, p1, 0, 0, 0); }
#pragma unroll
    for (int dd = 0; dd < 4; ++dd) {
        bf16x8 b0 = *reinterpret_cast<const bf16x8*>(krb[dd]);
        bf16x8 b1 = *reinterpret_cast<const bf16x8*>(krb[dd] + 16 * 256);
        const bf16x8 qf = *reinterpret_cast<const bf16x8*>(qrl + KRSWZ(r32, dd * 2 + hi));
        p0 = __builtin_amdgcn_mfma_f32_32x32x16_bf16(b0, qf, p0, 0, 0, 0);
        p1 = __builtin_amdgcn_mfma_f32_32x32x16_bf16(b1, qf, p1, 0, 0, 0); }
}
template <int KB>
__device__ __forceinline__ void qkt_fin(f32x16& p0, f32x16& p1, const char* lds, int r32, int hi, const bf16x8* qr, const char* qrl, float c0,
                                        const f32x16& y0, const f32x16& y1, float alpha, float& l_reg, bf16x8& pa0, bf16x8& pa1, bf16x8& pa2, bf16x8& pa3) {
#pragma unroll
    for (int r = 0; r < 16; ++r) { p0[r] = c0; p1[r] = c0; }
    int sw = (r32 & 15) << 4; asm volatile("" : "+v"(sw));
    const char* kbase = lds + OFF_KN + KB * SHM_KN + r32 * 256; const char* krb[4];
#pragma unroll
    for (int dd = 0; dd < 4; ++dd) krb[dd] = lds + OFF_KR + KB * SHM_KR + KRSWZ(r32, dd * 2 + hi);
#define QF_LOADK(d0_, B0_, B1_, QF_) do { if ((d0_) < 8) { const char* a_ = kbase + ((((d0_) * 16 + hi * 8) * 2) ^ sw); B0_ = *reinterpret_cast<const bf16x8*>(a_); B1_ = *reinterpret_cast<const bf16x8*>(a_ + 32 * 256); if ((d0_) < QPARK) QF_ = qr[(d0_) & 7]; else QF_ = *reinterpret_cast<const bf16x8*>(qrl + 4096 + (((d0_) & 7) - QPARK) * 1024 + (r32 + 32 * hi) * 16); } \
        else { B0_ = *reinterpret_cast<const bf16x8*>(krb[(d0_) & 3]); B1_ = *reinterpret_cast<const bf16x8*>(krb[(d0_) & 3] + 16 * 256); QF_ = *reinterpret_cast<const bf16x8*>(qrl + KRSWZ(r32, ((d0_) & 3) * 2 + hi)); } } while (0)
#define PK4(P, B_, OUT) do { unsigned a0 = cvtpk_a(P[B_+0], P[B_+1]), a1 = cvtpk_a(P[B_+2], P[B_+3]);                          \
        unsigned b0_ = cvtpk_a(P[B_+4], P[B_+5]), b1_ = cvtpk_a(P[B_+6], P[B_+7]);                                             \
        auto r0 = __builtin_amdgcn_permlane32_swap(a0, b0_, false, false); auto r1 = __builtin_amdgcn_permlane32_swap(a1, b1_, false, false); \
        u32x4 w = {r0[0], r1[0], r0[1], r1[1]}; OUT = *reinterpret_cast<bf16x8*>(&w); } while (0)
    float s0 = 0.f, s1 = 0.f, s2 = 0.f, s3 = 0.f;
    bf16x8 kb0, kb1, qf;
    QF_LOADK(0, kb0, kb1, qf);
#define QF_STEP(d0_) do { \
        p0 = __builtin_amdgcn_mfma_f32_32x32x16_bf16(kb0, qf, p0, 0, 0, 0); p1 = __builtin_amdgcn_mfma_f32_32x32x16_bf16(kb1, qf, p1, 0, 0, 0); \
        if ((d0_) + 1 < 12) QF_LOADK((d0_) + 1, kb0, kb1, qf);            \
        if ((d0_) < 4) { s0 += y0[4 * (d0_)]; s1 += y0[4 * (d0_) + 1]; s2 += y0[4 * (d0_) + 2]; s3 += y0[4 * (d0_) + 3]; } \
        else if ((d0_) < 8) { s0 += y1[4 * ((d0_) - 4)]; s1 += y1[4 * ((d0_) - 4) + 1]; s2 += y1[4 * ((d0_) - 4) + 2]; s3 += y1[4 * ((d0_) - 4) + 3]; } \
        if ((d0_) == 8) { float ps = (s0 + s1) + (s2 + s3); auto rr = __builtin_amdgcn_permlane32_swap(__float_as_uint(ps), __float_as_uint(ps), false, false); ps = __uint_as_float(rr[0]) + __uint_as_float(rr[1]); l_reg = l_reg * alpha + ps; PK4(y0, 0, pa0); } \
        if ((d0_) == 9) PK4(y0, 8, pa1); if ((d0_) == 10) PK4(y1, 0, pa2); if ((d0_) == 11) PK4(y1, 8, pa3); \
        SBAR(); } while (0)
    QF_STEP(0); QF_STEP(1); QF_STEP(2); QF_STEP(3); QF_STEP(4); QF_STEP(5); QF_STEP(6); QF_STEP(7); QF_STEP(8); QF_STEP(9); QF_STEP(10); QF_STEP(11);
#undef QF_STEP
#undef QF_LOADK
#undef PK4
}
template <int VB>
__device__ __forceinline__ void pv_tile(f32x16* o, int vb0, bf16x8 pa0, bf16x8 pa1, bf16x8 pa2, bf16x8 pa3) {
#define TRRD(dst, off) asm volatile("ds_read_b64_tr_b16 %0, %1 offset:%2" : "=&v"(dst) : "v"(vb0), "i"(off) : "memory")
#define PV_D0(d0) do { s16x4 l0, l1, l2, l3, h0, h1, h2, h3; constexpr int b_ = OFF_V + VB * SHM_V + v_rd_off(d0, 0, 0);     \
        TRRD(l0, b_); TRRD(h0, b_ + 2048); TRRD(l1, b_ + 4096); TRRD(h1, b_ + 6144); TRRD(l2, b_ + 8192); TRRD(h2, b_ + 10240); TRRD(l3, b_ + 12288); TRRD(h3, b_ + 14336); \
        asm volatile("s_waitcnt lgkmcnt(0)" ::: "memory"); SBAR();   \
        o[d0] = __builtin_amdgcn_mfma_f32_32x32x16_bf16(pa0, (bf16x8){l0[0], l0[1], l0[2], l0[3], h0[0], h0[1], h0[2], h0[3]}, o[d0], 0, 0, 0);   \
        o[d0] = __builtin_amdgcn_mfma_f32_32x32x16_bf16(pa1, (bf16x8){l1[0], l1[1], l1[2], l1[3], h1[0], h1[1], h1[2], h1[3]}, o[d0], 0, 0, 0);   \
        o[d0] = __builtin_amdgcn_mfma_f32_32x32x16_bf16(pa2, (bf16x8){l2[0], l2[1], l2[2], l2[3], h2[0], h2[1], h2[2], h2[3]}, o[d0], 0, 0, 0);   \
        o[d0] = __builtin_amdgcn_mfma_f32_32x32x16_bf16(pa3, (bf16x8){l3[0], l3[1], l3[2], l3[3], h3[0], h3[1], h3[2], h3[3]}, o[d0], 0, 0, 0); } while (0)
    PV_D0(0); PV_D0(1); PV_D0(2); PV_D0(3);
#undef PV_D0
#undef TRRD
}
template <int VB>
__device__ __forceinline__ void pv_exp_tile(f32x16* o, int vb0, bf16x8 pa0, bf16x8 pa1, bf16x8 pa2, bf16x8 pa3, f32x16& p0, f32x16& p1) {
#define TRRD(dst, off) asm volatile("ds_read_b64_tr_b16 %0, %1 offset:%2" : "=&v"(dst) : "v"(vb0), "i"(off) : "memory")
#define EX2(P, i) do { float e0_, e1_; asm volatile("v_exp_f32_e32 %0, %2\n\tv_exp_f32_e32 %1, %3" : "=&v"(e0_), "=&v"(e1_) : "v"(P[i]), "v"(P[(i) + 1])); P[i] = e0_; P[(i) + 1] = e1_; } while (0)
#define PVX_D0(d0, P) do { s16x4 l0, l1, l2, l3, h0, h1, h2, h3; constexpr int b_ = OFF_V + VB * SHM_V + v_rd_off(d0, 0, 0);     \
        TRRD(l0, b_); TRRD(h0, b_ + 2048); TRRD(l1, b_ + 4096); TRRD(h1, b_ + 6144); TRRD(l2, b_ + 8192); TRRD(h2, b_ + 10240); TRRD(l3, b_ + 12288); TRRD(h3, b_ + 14336); \
        asm volatile("s_waitcnt lgkmcnt(0)" ::: "memory"); SBAR();   \
        o[d0] = __builtin_amdgcn_mfma_f32_32x32x16_bf16(pa0, (bf16x8){l0[0], l0[1], l0[2], l0[3], h0[0], h0[1], h0[2], h0[3]}, o[d0], 0, 0, 0); EX2(P, ((d0) & 1) * 8 + 0); SBAR();  \
        o[d0] = __builtin_amdgcn_mfma_f32_32x32x16_bf16(pa1, (bf16x8){l1[0], l1[1], l1[2], l1[3], h1[0], h1[1], h1[2], h1[3]}, o[d0], 0, 0, 0); EX2(P, ((d0) & 1) * 8 + 2); SBAR();  \
        o[d0] = __builtin_amdgcn_mfma_f32_32x32x16_bf16(pa2, (bf16x8){l2[0], l2[1], l2[2], l2[3], h2[0], h2[1], h2[2], h2[3]}, o[d0], 0, 0, 0); EX2(P, ((d0) & 1) * 8 + 4); SBAR();  \
        o[d0] = __builtin_amdgcn_mfma_f32_32x32x16_bf16(pa3, (bf16x8){l3[0], l3[1], l3[2], l3[3], h3[0], h3[1], h3[2], h3[3]}, o[d0], 0, 0, 0); EX2(P, ((d0) & 1) * 8 + 6); SBAR(); } while (0)
    PVX_D0(0, p0); PVX_D0(1, p0); PVX_D0(2, p1); PVX_D0(3, p1);
#undef PVX_D0
#undef EX2
#undef TRRD
}
__device__ __forceinline__ void attn_block(int b, int h, int qb, const bf16_t* Q, const bf16_t* KN, const bf16_t* KR, const bf16_t* V, bf16_t* O, char* lds, LAS unsigned char* ldsl, const float* qg, const float* CS, int wid_in) {
    const int wid = wid_in; int lane_ = lane_id_v();
    const int lane = lane_, tid = wid * 64 + lane, r32 = lane & 31, hi = lane >> 5;
    const size_t tok0 = (size_t)b * SEQ; const int q0 = qb * 256; const int NT = 4 * qb + 4;
    const int qlo = q0 + wid * 32, qm = qlo + r32 - 4 * hi;
    float* wsf = (float*)(lds + OFF_WS) + wid * 64; float* li_l = wsf, * al_l = wsf + 32;
    const char* knb = (const char*)(KN + tok0 * 1024 + h * 128); const char* vbs = (const char*)(V + tok0 * 1024 + h * 128); const char* krbs = (const char*)(KR + (tok0 * NH + h) * ROPE);
    unsigned so_k[2], so_v[2], so_r;
#pragma unroll
    for (int i = 0; i < 2; ++i) { const int pp = wid * 2 + i;
        { const int row = 4 * pp + (lane >> 4), c = (lane & 15) ^ (row & 15); so_k[i] = (unsigned)(row * 2048 + c * 16); }
        { const int st = 2 * pp + (lane >> 5), kk = (st >> 2) * 8 + ((lane >> 2) & 7), k = (kk & ~0xC) | ((kk & 4) << 1) | ((kk & 8) >> 1), col = (st & 3) * 32 + (lane & 3) * 8; so_v[i] = (unsigned)(k * 2048 + col * 2); } }
    { const int pair = 4 * wid + (lane >> 4), sl = (lane & 15) ^ (pair & 7), row = 2 * pair + (sl >> 3); so_r = (unsigned)(row * (NH * ROPE * 2) + (sl & 7) * 16); }
    const int vb0 = (int)(uintptr_t)lds + v_rd_base(lane);
#define DMA_K(t, kb_) do { const char* k_ = knb + (size_t)(t) * 64 * 1024 * 2; const char* r_ = krbs + (size_t)(t) * 64 * NH * ROPE * 2; \
        _Pragma("unroll") for (int i_ = 0; i_ < 2; ++i_) __builtin_amdgcn_global_load_lds((const unsigned*)(k_ + so_k[i_]), (LAS unsigned*)(ldsl + OFF_KN + (kb_) * SHM_KN + (wid * 2 + i_) * 1024), 16, 0, 0); \
        __builtin_amdgcn_global_load_lds((const unsigned*)(r_ + so_r), (LAS unsigned*)(ldsl + OFF_KR + (kb_) * SHM_KR + wid * 1024), 16, 0, 0); } while (0)
#define DMA_V(t, vo_) do { const char* v_ = vbs + (size_t)(t) * 64 * 1024 * 2; \
        _Pragma("unroll") for (int i_ = 0; i_ < 2; ++i_) __builtin_amdgcn_global_load_lds((const unsigned*)(v_ + so_v[i_]), (LAS unsigned*)(ldsl + OFF_V + (vo_) + (wid * 2 + i_) * 1024), 16, 0, 0); } while (0)
#define VMW() asm volatile("s_waitcnt vmcnt(0)" ::: "memory")
    DMA_K(0, 0); DMA_V(0, 0);
    bf16x8 qr[12];
    { const bf16_t* qrow = Q + ((tok0 + qlo + r32) * NH + h) * QKD + hi * 8;
#pragma unroll
      for (int d0 = 0; d0 < 12; ++d0) qr[d0] = *reinterpret_cast<const bf16x8*>(qrow + d0 * 16);
      float ss = 0.f;
#pragma unroll
      for (int d0 = 0; d0 < 12; ++d0) { f32x4 a, b; unpack8(__builtin_bit_cast(u32x4, qr[d0]), a, b); ss += (a.x * a.x + a.y * a.y) + (a.z * a.z + a.w * a.w) + (b.x * b.x + b.y * b.y) + (b.z * b.z + b.w * b.w); }
      ss += __shfl_xor(ss, 32);
      const float rs = QSCALE / sqrtf(ss * (1.0f / 192.0f) + EPS);
      const float* gp = qg + hi * 8;
#pragma unroll
      for (int d0 = 0; d0 < 8; ++d0) { f32x4 a, b; unpack8(__builtin_bit_cast(u32x4, qr[d0]), a, b); const f32x4 g0 = *(const f32x4*)(gp + d0 * 16), g1 = *(const f32x4*)(gp + d0 * 16 + 4);
          qr[d0] = __builtin_bit_cast(bf16x8, pack8(a * rs * g0, b * rs * g1)); }
      const float* cs = CS + (tok0 + qlo + r32) * 64 + hi * 8;
#pragma unroll
      for (int dd = 0; dd < 2; ++dd) { f32x4 a1, b1, a2, b2; unpack8(__builtin_bit_cast(u32x4, qr[8 + dd]), a1, b1); unpack8(__builtin_bit_cast(u32x4, qr[10 + dd]), a2, b2);
          const f32x4 g10 = *(const f32x4*)(gp + 128 + dd * 16), g11 = *(const f32x4*)(gp + 128 + dd * 16 + 4), g20 = *(const f32x4*)(gp + 160 + dd * 16), g21 = *(const f32x4*)(gp + 160 + dd * 16 + 4);
          const f32x4 c0 = *(const f32x4*)(cs + dd * 16), c1 = *(const f32x4*)(cs + dd * 16 + 4), s0 = *(const f32x4*)(cs + 32 + dd * 16), s1 = *(const f32x4*)(cs + 32 + dd * 16 + 4);
          a1 = a1 * rs * g10; b1 = b1 * rs * g11; a2 = a2 * rs * g20; b2 = b2 * rs * g21;
          qr[8 + dd] = __builtin_bit_cast(bf16x8, pack8(a1 * c0 - a2 * s0, b1 * c1 - b2 * s1)); qr[10 + dd] = __builtin_bit_cast(bf16x8, pack8(a2 * c0 + a1 * s0, b2 * c1 + b1 * s1)); }
#pragma unroll
      for (int dd = 0; dd < 4; ++dd) *reinterpret_cast<bf16x8*>(lds + OFF_QR + wid * QR_WAVE + KRSWZ(r32, dd * 2 + hi)) = qr[8 + dd];
#pragma unroll
      for (int d0 = QPARK; d0 < 8; ++d0) *reinterpret_cast<bf16x8*>(lds + OFF_QR + wid * QR_WAVE + 4096 + (d0 - QPARK) * 1024 + lane * 16) = qr[d0]; }
    const char* qrl = lds + OFF_QR + wid * QR_WAVE;
    float m_reg = -1e30f, l_reg = 0.f; f32x16 o[4] = {};
    f32x16 pA0, pA1, pB0, pB1; bf16x8 pa0, pa1, pa2, pa3; float alA, alB;
#define RESC(a) do { if (__any((a) < 1.f)) { if (hi == 0) al_l[r32] = (a); asm volatile("s_waitcnt lgkmcnt(0)" ::: "memory");              \
                     _Pragma("unroll") for (int d_ = 0; d_ < 4; ++d_) _Pragma("unroll") for (int r = 0; r < 16; ++r) o[d_][r] *= al_l[crow(r, hi)]; } } while (0)
#define MASKT(P0_, P1_, t) do { const int kb_ = (t) * 64; if (kb_ + 63 > qlo) mask_tile(P0_, P1_, qm - kb_); } while (0)
    int vo_prev = 0, vo_cur = 0, vo_next = SHM_V;
#define ROTV() do { vo_prev = vo_cur; vo_cur = vo_next; vo_next = (vo_next == 2 * SHM_V) ? 0 : vo_next + SHM_V; } while (0)
    VMW(); __syncthreads();
    DMA_K(1, 1); DMA_V(1, SHM_V); SBAR();
    qkt<0>(pA0, pA1, lds, r32, hi, qr, qrl, 0.f); MASKT(pA0, pA1, 0); partialSM(pA0, pA1, m_reg, alA);
    VMW(); __syncthreads(); ROTV();
#define HALF_STEP(PX0, PX1, alX, PY0, PY1, alY, t, KB) do { const bool more = (t) + 1 < NT;                     \
        if (more) { DMA_K((t) + 1, (KB) ^ 1); DMA_V((t) + 1, vo_next); } SBAR();                                   \
        qkt_fin<KB>(PX0, PX1, lds, r32, hi, qr, qrl, -m_reg, PY0, PY1, alY, l_reg, pa0, pa1, pa2, pa3); SBAR();        \
        MASKT(PX0, PX1, t); rowmaxSM_rel(PX0, PX1, m_reg, alX); SBAR();                                           \
        pv_exp_tile<0>(o, vb0 + vo_prev, pa0, pa1, pa2, pa3, PX0, PX1);                                           \
        RESC(alX);                                                                                                \
        VMW(); __syncthreads(); ROTV(); } while (0)
    for (int t = 1; t + 1 < NT; t += 2) {
        HALF_STEP(pB0, pB1, alB, pA0, pA1, alA, t, 1);
        HALF_STEP(pA0, pA1, alA, pB0, pB1, alB, t + 1, 0);
    }
    HALF_STEP(pB0, pB1, alB, pA0, pA1, alA, NT - 1, 1);
    finishSM(pB0, pB1, alB, l_reg, pa0, pa1, pa2, pa3); SBAR();
    pv_tile<0>(o, vb0 + vo_prev, pa0, pa1, pa2, pa3);
    if (hi == 0) li_l[r32] = l_reg; asm volatile("s_waitcnt lgkmcnt(0)" ::: "memory");
    float rli[16];
#pragma unroll
    for (int r = 0; r < 16; ++r) rli[r] = __builtin_amdgcn_rcpf(li_l[crow(r, hi)]);
    int hi_o = hi; asm volatile("" : "+v"(hi_o));
    bf16_t* Ow = O + (tok0 + qlo + 4 * hi_o) * 1024 + h * 128 + r32;
#pragma unroll
    for (int r = 0; r < 16; ++r) { const int orow = (r & 3) + 8 * (r >> 2);
#pragma unroll
        for (int d0 = 0; d0 < 4; ++d0) { const float v = o[d0][r] * rli[r]; const float vn = __shfl_xor(v, 1);
            if ((r32 & 1) == 0) *(unsigned*)(Ow + orow * 1024 + d0 * 32) = cvtpk(v, vn); } }
    __syncthreads();
#undef DMA_K
#undef DMA_V
#undef MASKT
#undef ROTV
#undef HALF_STEP
#undef VMW
#undef RESC
}
#undef KSWZ
#undef KRSWZ
#undef SBAR
}

__device__ __forceinline__ void tr_load(float (&v)[32], const float* src, size_t lsrc, int lane) {
    asm volatile("" : "+v"(lane));
    const float* sp = src + (size_t)(lane >> 5) * lsrc + (lane & 31);
#pragma unroll
    for (int i = 0; i < 32; ++i) v[i] = __builtin_nontemporal_load(sp + (size_t)(2 * i) * lsrc);
}
__device__ __forceinline__ void tr_finish(const float (&v)[32], bf16_t* dst, size_t ldd, LAS float* scr, int lane, const float* gk = nullptr) {
#pragma unroll
    for (int i = 0; i < 32; ++i) scr[(2 * i + (lane >> 5)) * 33 + (lane & 31)] = v[i];
    LDS_WAIT(); asm volatile("" ::: "memory");
    const int c = lane & 7;
    f32x4 g0 = {1.f, 1.f, 1.f, 1.f}, g1 = g0;
    if (gk) { g0 = *(const f32x4*)(gk + 8 * c); g1 = *(const f32x4*)(gk + 8 * c + 4); }
#pragma unroll
    for (int j = 0; j < 4; ++j) { const int n = (lane >> 3) + 8 * j; const LAS float* s = scr + (8 * c) * 33 + n;
        u32x4 o; o.x = cvtpk(s[0 * 33] * g0.x, s[1 * 33] * g0.y); o.y = cvtpk(s[2 * 33] * g0.z, s[3 * 33] * g0.w); o.z = cvtpk(s[4 * 33] * g1.x, s[5 * 33] * g1.y); o.w = cvtpk(s[6 * 33] * g1.z, s[7 * 33] * g1.w);
        *(u32x4*)(dst + (size_t)n * ldd + 8 * c) = o; }
    LDS_WAIT(); asm volatile("" ::: "memory");
}
__device__ __forceinline__ void tr_item(const float* src, size_t lsrc, bf16_t* dst, size_t ldd, LAS float* scr, int lane) { float v[32]; tr_load(v, src, lsrc, lane); tr_finish(v, dst, ldd, scr, lane); }
__device__ __forceinline__ void rms_row_to_bf16(const float* xrow, const float* g, bf16_t* orow, int lane) {
    f32x4 v[4]; float s = 0.f;
#pragma unroll
    for (int j = 0; j < 4; ++j) { v[j] = *(const f32x4*)(xrow + 4 * lane + 256 * j); s += (v[j].x * v[j].x + v[j].y * v[j].y) + (v[j].z * v[j].z + v[j].w * v[j].w); }
    const float rs = 1.0f / sqrtf(wave_sum(s) * (1.0f / 1024.0f) + EPS);
#pragma unroll
    for (int j = 0; j < 4; ++j) { const f32x4 gg = *(const f32x4*)(g + 4 * lane + 256 * j); const f32x4 y = v[j] * rs * gg;
        *(u32x2*)(orow + 4 * lane + 256 * j) = (u32x2){cvtpk(y.x, y.y), cvtpk(y.z, y.w)}; }
}

__device__ __forceinline__ void rms_row2_to_bf16(const float* xa, const float* xb, const float* g, bf16_t* oa, bf16_t* ob, int lane) {
    f32x4 va[4], vb[4]; float sa = 0.f, sb = 0.f;
#pragma unroll
    for (int j = 0; j < 4; ++j) { va[j] = *(const f32x4*)(xa + 4 * lane + 256 * j); vb[j] = *(const f32x4*)(xb + 4 * lane + 256 * j); }
#pragma unroll
    for (int j = 0; j < 4; ++j) { sa += (va[j].x * va[j].x + va[j].y * va[j].y) + (va[j].z * va[j].z + va[j].w * va[j].w); sb += (vb[j].x * vb[j].x + vb[j].y * vb[j].y) + (vb[j].z * vb[j].z + vb[j].w * vb[j].w); }
    const float ra = 1.0f / sqrtf(wave_sum(sa) * (1.0f / 1024.0f) + EPS), rb = 1.0f / sqrtf(wave_sum(sb) * (1.0f / 1024.0f) + EPS);
#pragma unroll
    for (int j = 0; j < 4; ++j) { const f32x4 gg = *(const f32x4*)(g + 4 * lane + 256 * j); const f32x4 ya = va[j] * ra * gg, yb = vb[j] * rb * gg;
        *(u32x2*)(oa + 4 * lane + 256 * j) = (u32x2){cvtpk(ya.x, ya.y), cvtpk(ya.z, ya.w)}; *(u32x2*)(ob + 4 * lane + 256 * j) = (u32x2){cvtpk(yb.x, yb.y), cvtpk(yb.z, yb.w)}; }
}
__device__ __forceinline__ void p1b_rope_table(Frame& F, const Args& A, int part, int nparts) {
    const int gt = (part * 8 + F.wave) * 64 + F.lane, GT = nparts * 8 * 64;
    { float* CS = (float*)((unsigned char*)F.out + OUT_CS); const int* pos = (const int*)A.in[1];
      for (int i = gt; i < NTOK * 32; i += GT) { const int tok = i >> 5, fi = i & 31; const float ang = (float)pos[tok] * A.invf[fi];
          const float kq = __builtin_rintf(ang * 0.15915494309189535f);
          float rr = __builtin_fmaf(-kq, 6.28318548202514648f, ang); rr = __builtin_fmaf(-kq, -1.74845553e-7f, rr);
          const float fr = rr * 0.15915494309189535f;
          CS[tok * 64 + fi] = __builtin_amdgcn_cosf(fr); CS[tok * 64 + 32 + fi] = __builtin_amdgcn_sinf(fr); } }
}
constexpr int P0_I_IN = 16 * 146, P0_I_SQ = 16 * 32, P0_I_UQ = 4 * 48, P0_I_UKV = 4 * 64, P0_I_G = 64;
constexpr int P0_NITEMS = P0_I_IN + 3 * P0_I_SQ + P0_I_UQ + P0_I_UKV + 2 * P0_I_G;
__device__ __forceinline__ void p0_copies(Frame& F, const Args& A, int it_lo, int it_hi, int gw, int ngw) {
    LAS float* scr = (LAS float*)(F.lds + F.wave * 16384);
    unsigned char* ws = F.ws;
    bf16_t* WinT = (bf16_t*)(ws + WS_WIN); bf16_t* WuqT = (bf16_t*)(ws + WS_WUQ); bf16_t* Wgate = (bf16_t*)(ws + WS_WGATE);
    constexpr int I_IN = P0_I_IN, I_SQ = P0_I_SQ, I_UQ = P0_I_UQ, I_UKV = P0_I_UKV, I_G = P0_I_G;
    __syncthreads();
    for (int it = it_lo + gw; it < it_hi; it += ngw) {
        int r = it;
        if (r < I_IN) { const int kb = r / 146, nb = r % 146, n0 = 32 * nb;
            const int dr = n0 < 2624 ? n0 : (n0 < 3648 ? 2816 + 256 * ((n0 - 2624) >> 7) + ((n0 - 2624) & 127) : 2816 + 256 * ((n0 - 3648) >> 7) + 128 + ((n0 - 3648) & 127));
            tr_item((const float*)A.in[3] + (size_t)(64 * kb) * 4672 + n0, 4672, WinT + (size_t)dr * 1024 + 64 * kb, 1024, scr, F.lane); continue; } r -= I_IN;
        if (r < 3 * I_SQ) { const int w = r / I_SQ, q = r % I_SQ, kb = q / 32, nb = q % 32; const float* src = (const float*)A.in[w == 0 ? 11 : (w == 1 ? 18 : 19)];
            bf16_t* dst = (bf16_t*)(ws + (w == 2 ? WS_WOUT : WS_WRNN)) + (w == 1 ? 1024 : 0); const size_t ldd = (w == 2) ? 1024 : 2048;
            tr_item(src + (size_t)(64 * kb) * 1024 + 32 * nb, 1024, dst + (size_t)(32 * nb) * ldd + 64 * kb, ldd, scr, F.lane); continue; } r -= 3 * I_SQ;
        if (r < I_UQ) { const int kb = r / 48, nb = r % 48, n0 = 32 * nb;
            tr_item((const float*)A.in[13] + (size_t)(64 * kb) * 1536 + n0, 1536, WuqT + (size_t)n0 * 256 + 64 * kb, 256, scr, F.lane); continue; } r -= I_UQ;
        if (r < I_UKV) { const int kb = r / 64, nb = r % 64;
            tr_item((const float*)A.in[15] + (size_t)(64 * kb) * 2048 + 32 * nb, 2048, (bf16_t*)(ws + WS_WUKV) + (size_t)(32 * nb) * 256 + 64 * kb, 256, scr, F.lane); continue; } r -= I_UKV;
        { const int which = r / I_G, q = r % I_G, blk = q / 8, kb = (q % 8) / 4, nb = q % 4;
          const float* src = (const float*)A.in[which == 0 ? 6 : 8] + (size_t)blk * 128 * 128 + (size_t)(64 * kb) * 128 + 32 * nb;
          tr_item(src, 128, Wgate + (size_t)(blk * 256 + which * 128 + 32 * nb) * 128 + 64 * kb, 128, scr, F.lane); }
    }
}
__device__ __forceinline__ void p0_prologue(Frame& F, const Args& A) {
    unsigned char* ws = F.ws; bf16_t* WinT = (bf16_t*)(ws + WS_WIN);
    p0_copies(F, A, 0, P0_I_IN, F.gw, F.NGW);
#ifdef PROBE_P0
    STAMPX(F, 3);
#endif
    const int gt = F.gw * 64 + F.lane, GT = F.NGW * 64; const u32x4 z4 = {0u, 0u, 0u, 0u};
    for (int i = gt; i < 192 * 128; i += GT) *(u32x4*)(WinT + (size_t)2624 * 1024 + (size_t)i * 8) = z4;
    float* c8 = (float*)(ws + WS_C8); float* Wr = (float*)(ws + WS_WR); float* br = (float*)(ws + WS_BR);
    for (int i = gt; i < 1024; i += GT) c8[i] = 8.0f * log1pf(expf(-((const float*)A.in[10])[i]));
    { bf16_t* WrH = (bf16_t*)Wr; bf16_t* WrL = WrH + 96 * 1024;
      for (int i = gt; i < 1024 * 96; i += GT) { const int c = i >> 10, k = i & 1023; const float w = ((const float*)A.in[20])[k] * (c < 8 ? ((const float*)A.in[21])[k * 8 + c] : (c < 72 ? ((const float*)A.in[23])[k * 64 + c - 8] : 0.f));
          const unsigned hb = cvtpk(w, 0.f) & 0xffffu; const float lo = w - __uint_as_float(hb << 16); WrH[i] = (bf16_t)hb; WrL[i] = (bf16_t)(cvtpk(lo, 0.f) & 0xffffu); } }
    for (int i = gt; i < 72; i += GT) br[i] = i < 8 ? ((const float*)A.in[22])[i] : ((const float*)A.in[24])[i - 8];
    const float* x = (const float*)A.in[0]; bf16_t* U = (bf16_t*)(ws + WS_U);
    { const float* g1 = (const float*)A.in[2]; f32x4 gg[4];
#pragma unroll
      for (int j = 0; j < 4; ++j) gg[j] = *(const f32x4*)(g1 + 4 * F.lane + 256 * j);
      for (int m = F.gw; m < NTOK; m += 4 * F.NGW) {
          f32x4 v[4][4];
#pragma unroll
          for (int i = 0; i < 4; ++i)
#pragma unroll
              for (int j = 0; j < 4; ++j) v[i][j] = __builtin_nontemporal_load((const f32x4*)(x + (size_t)(m + i * F.NGW) * DM + 4 * F.lane + 256 * j));
#pragma unroll
          for (int i = 0; i < 4; ++i) { float s = 0.f;
#pragma unroll
              for (int j = 0; j < 4; ++j) s += (v[i][j].x * v[i][j].x + v[i][j].y * v[i][j].y) + (v[i][j].z * v[i][j].z + v[i][j].w * v[i][j].w);
              const float rs = 1.0f / sqrtf(wave_sum(s) * (1.0f / 1024.0f) + EPS); bf16_t* o = U + (size_t)(m + i * F.NGW) * DM;
#pragma unroll
              for (int j = 0; j < 4; ++j) { const f32x4 y = v[i][j] * rs * gg[j]; *(u32x2*)(o + 4 * F.lane + 256 * j) = (u32x2){cvtpk(y.x, y.y), cvtpk(y.z, y.w)}; } } } }
}

#define LSWZ(row, c16) ((row) * 256 + ((((c16) * 16)) ^ (((row) & 7) << 4)))
__device__ __forceinline__ void px_lru(Frame& F, const Args& A) {
    unsigned char* ws = F.ws; char* lds = (char*)F.lds;
    constexpr int OFF_W = 0, OFF_A = 65536, OFF_AGG = L_LG;
    const int tid = F.tid, lane = F.lane, r32 = lane & 31, hi = lane >> 5, wr = F.wave >> 1, wc = F.wave & 1;
    const int j = F.vcu & 7, Tb = F.vcu >> 3, nun = (256 - Tb + (F.G / 8) - 1) / (F.G / 8);
    const bf16_t* XR = (const bf16_t*)(ws + WS_XR); unsigned short* LOGA = (unsigned short*)(ws + WS_LOGA); unsigned short* BIN = (unsigned short*)(ws + WS_BIN);
    f32x4* SUMM = (f32x4*)(ws + WS_SUMM);
    { const bf16_t* WG2 = (const bf16_t*)(ws + WS_WGATE) + (size_t)j * 256 * 128;
      for (int i = tid; i < 256 * 16; i += 512) { const int n = i >> 4, c = i & 15; *(u32x4*)(lds + OFF_W + LSWZ(n, c)) = *(const u32x4*)(WG2 + n * 128 + c * 8); } }
    const int cg = tid & 15, rg = tid >> 4, ch0 = j * 128 + cg * 8;
    float cwt[4][8], cbs[8];
    { const float* cw = (const float*)A.in[4]; const float* cb = (const float*)A.in[5];
#pragma unroll
      for (int k = 0; k < 4; ++k) { const f32x4 a = *(const f32x4*)(cw + k * 1024 + ch0), b = *(const f32x4*)(cw + k * 1024 + ch0 + 4);
          cwt[k][0] = a.x; cwt[k][1] = a.y; cwt[k][2] = a.z; cwt[k][3] = a.w; cwt[k][4] = b.x; cwt[k][5] = b.y; cwt[k][6] = b.z; cwt[k][7] = b.w; }
      const f32x4 a = *(const f32x4*)(cb + ch0), b = *(const f32x4*)(cb + ch0 + 4); cbs[0] = a.x; cbs[1] = a.y; cbs[2] = a.z; cbs[3] = a.w; cbs[4] = b.x; cbs[5] = b.y; cbs[6] = b.z; cbs[7] = b.w; }
    float gba[2], gbx[2], gc8[2];
#pragma unroll
    for (int p = 0; p < 2; ++p) { const int ch = j * 128 + 64 * wc + 32 * p + r32; gba[p] = ((const float*)A.in[7])[ch]; gbx[p] = ((const float*)A.in[9])[ch]; gc8[p] = ((const float*)(ws + WS_C8))[ch]; }
    u32x4 raw[7], nraw[7];
#define PX_LOAD(dst, T_) do { const int t0_ = (T_) * 128 + 4 * rg; const bool has_ = (rg != 0) || (((T_) & 63) != 0);     \
        _Pragma("unroll") for (int k = 0; k < 7; ++k) dst[k] = (k >= 3 || has_) ? __builtin_nontemporal_load((const u32x4*)(XR + (size_t)(t0_ - 3 + k) * 1024 + ch0)) : (u32x4){0u, 0u, 0u, 0u}; } while (0)
    if (nun > 0) PX_LOAD(raw, Tb);
    for (int ui = 0; ui < nun; ++ui) {
        const int T = Tb + (F.G / 8) * ui;
        {
            f32x4 x0[7], x1[7];
#pragma unroll
            for (int k = 0; k < 7; ++k) unpack8(raw[k], x0[k], x1[k]);
#pragma unroll
            for (int t = 0; t < 4; ++t) { f32x4 y0, y1;
#pragma unroll
                for (int q = 0; q < 4; ++q) { y0[q] = cbs[q] + cwt[0][q] * x0[t][q] + cwt[1][q] * x0[t + 1][q] + cwt[2][q] * x0[t + 2][q] + cwt[3][q] * x0[t + 3][q];
                                              y1[q] = cbs[4 + q] + cwt[0][4 + q] * x1[t][q] + cwt[1][4 + q] * x1[t + 1][q] + cwt[2][4 + q] * x1[t + 2][q] + cwt[3][4 + q] * x1[t + 3][q]; }
                *(u32x4*)(lds + OFF_A + LSWZ(4 * rg + t, cg)) = pack8(y0, y1); }
        }
        __syncthreads();
        if (ui + 1 < nun) PX_LOAD(nraw, T + (F.G / 8));
        bf16x8 af[8];
#pragma unroll
        for (int ks = 0; ks < 8; ++ks) af[ks] = *(const bf16x8*)(lds + OFF_A + LSWZ(32 * wr + r32, 2 * ks + hi));
#pragma unroll
        for (int p = 0; p < 2; ++p) {
            f32x16 aR = {}, aI = {};
            const int nl = 64 * wc + 32 * p + r32;
#pragma unroll
            for (int ks = 0; ks < 8; ++ks) { const bf16x8 bR = *(const bf16x8*)(lds + OFF_W + LSWZ(nl, 2 * ks + hi)), bI = *(const bf16x8*)(lds + OFF_W + LSWZ(128 + nl, 2 * ks + hi));
                aR = __builtin_amdgcn_mfma_f32_32x32x16_bf16(af[ks], bR, aR, 0, 0, 0); aI = __builtin_amdgcn_mfma_f32_32x32x16_bf16(af[ks], bI, aI, 0, 0, 0); }
            float la[16], bb[16], av[16];
#pragma unroll
            for (int r = 0; r < 16; ++r) { const int row = 32 * wr + (r & 3) + 8 * (r >> 2) + 4 * hi;
                const float xv = __uint_as_float((unsigned)(*(const unsigned short*)(lds + OFF_A + LSWZ(row, nl >> 3) + (nl & 7) * 2)) << 16);
                const float rgt = sigmoidf_(aR[r] + gba[p]), ib = 1.0f + __builtin_amdgcn_exp2f(-1.4426950408889634f * (aI[r] + gbx[p]));
                const float l = (float)(_Float16)(-gc8[p] * rgt);
                const float a = __builtin_amdgcn_exp2f(1.4426950408889634f * l);
                const float y = (1.0f - a) * (1.0f + a);
                la[r] = l; av[r] = a; bb[r] = xv * y * __builtin_amdgcn_rsqf(fmaxf(y * ib * ib, 1e-30f)); }
            { const size_t base = (((size_t)T * 16 + 4 * wr) * 1024 + (size_t)(j * 128 + nl)) * 8 + 4 * hi;
#pragma unroll
              for (int s = 0; s < 4; ++s) { *(u32x2*)(LOGA + base + (size_t)s * 8192) = (u32x2){cvtpk_h(la[4 * s], la[4 * s + 1]), cvtpk_h(la[4 * s + 2], la[4 * s + 3])};
                                            *(u32x2*)(BIN + base + (size_t)s * 8192) = (u32x2){cvtpk(bb[4 * s], bb[4 * s + 1]), cvtpk(bb[4 * s + 2], bb[4 * s + 3])}; } }
            float sl[4], hs[4];
#pragma unroll
            for (int s = 0; s < 4; ++s) { sl[s] = (av[4 * s] * av[4 * s + 1]) * (av[4 * s + 2] * av[4 * s + 3]);
                hs[s] = ((bb[4 * s] * av[4 * s + 1] + bb[4 * s + 1]) * av[4 * s + 2] + bb[4 * s + 2]) * av[4 * s + 3] + bb[4 * s + 3]; }
            float SL = 1.f, H = 0.f;
#pragma unroll
            for (int s = 0; s < 4; ++s) { const float osl = __shfl_xor(sl[s], 32), ohs = __shfl_xor(hs[s], 32);
                const float sl_a = hi ? osl : sl[s], hs_a = hi ? ohs : hs[s], sl_b = hi ? sl[s] : osl, hs_b = hi ? hs[s] : ohs;
                H = H * sl_a + hs_a; SL *= sl_a; H = H * sl_b + hs_b; SL *= sl_b; }
            if (hi == 0) *(f32x2_t*)(lds + OFF_AGG + (wr * 128 + nl) * 8) = (f32x2_t){SL, H};
        }
        __syncthreads();
        if (tid < 64) { float s0 = 1.f, h0 = 0.f, s1 = 1.f, h1 = 0.f;
#pragma unroll
            for (int w = 0; w < 4; ++w) { const f32x4 g = *(const f32x4*)(lds + OFF_AGG + (w * 128 + 2 * tid) * 8); h0 = h0 * g.x + g.y; s0 *= g.x; h1 = h1 * g.z + g.w; s1 *= g.z; }
            SUMM[(size_t)T * 512 + j * 64 + tid] = (f32x4){s0, h0, s1, h1}; }
#pragma unroll
        for (int k = 0; k < 7; ++k) raw[k] = nraw[k];
    }
#undef PX_LOAD
#ifdef PROBE_PX
    STAMPX(F, 4);
#endif
    { const f32x4 gq = *(const f32x4*)((const float*)A.in[12] + 4 * F.lane), gk = *(const f32x4*)((const float*)A.in[14] + 4 * F.lane);
      for (int tok0 = F.gw; tok0 < NTOK; tok0 += 4 * F.NGW) { u32x2 wq[4], wk[4];
unsigned short wp[4];
#pragma unroll
        for (int i = 0; i < 4; ++i) { const size_t tok = (size_t)tok0 + (size_t)i * F.NGW; wq[i] = __builtin_nontemporal_load((const u32x2*)((const bf16_t*)(ws + WS_CQ) + tok * 256 + 4 * F.lane)); wk[i] = __builtin_nontemporal_load((const u32x2*)((const bf16_t*)(ws + WS_CKV) + tok * 256 + 4 * F.lane)); wp[i] = ((const bf16_t*)(ws + WS_KPE))[tok * ROPE + F.lane]; }
#pragma unroll
        for (int i = 0; i < 4; ++i) { const size_t tok = (size_t)tok0 + (size_t)i * F.NGW;
            { const float a = bflo(wq[i].x), b = bfhi(wq[i].x), c = bflo(wq[i].y), d = bfhi(wq[i].y); const float rs = 1.0f / sqrtf(wave_sum(a * a + b * b + c * c + d * d) * (1.0f / 256.0f) + EPS);
              *(u32x2*)((bf16_t*)(ws + WS_CQN) + tok * 256 + 4 * F.lane) = (u32x2){cvtpk(a * rs * gq.x, b * rs * gq.y), cvtpk(c * rs * gq.z, d * rs * gq.w)}; }
            { const float a = bflo(wk[i].x), b = bfhi(wk[i].x), c = bflo(wk[i].y), d = bfhi(wk[i].y); const float rs = 1.0f / sqrtf(wave_sum(a * a + b * b + c * c + d * d) * (1.0f / 256.0f) + EPS);
              *(u32x2*)((bf16_t*)(ws + WS_CKVN) + tok * 256 + 4 * F.lane) = (u32x2){cvtpk(a * rs * gk.x, b * rs * gk.y), cvtpk(c * rs * gk.z, d * rs * gk.w)}; }
            { const float a = __uint_as_float((unsigned)wp[i] << 16); const float s = wave_sum(a * a); if (F.lane == 0) ((float*)(ws + WS_KPESS))[tok] = s; } } } }
}
#undef LSWZ

__device__ __forceinline__ void py_scan(Frame& F) {
    unsigned char* ws = F.ws;
    const unsigned short* LOGA = (const unsigned short*)(ws + WS_LOGA); const unsigned short* BIN = (const unsigned short*)(ws + WS_BIN);
    const unsigned* GY = (const unsigned*)(ws + WS_GY); unsigned* Z = (unsigned*)(ws + WS_Z); const f32x4* SUMM = (const f32x4*)(ws + WS_SUMM);
    for (int u = F.vcu; u < NB * 64; u += F.G) {
        const int c = u & 63; float h0 = 0.f, h1 = 0.f;
        const size_t cb = ((size_t)u * 16 * 1024 + 2 * F.tid) * 8, zb = (size_t)u * 128 * 512 + F.tid;
        u32x4 la0[2][2], la1[2][2], b0[2][2], b1[2][2]; unsigned gg[2][16];
#define PY_LOAD(s_, t0_) do { _Pragma("unroll") for (int q = 0; q < 2; ++q) { const size_t go = cb + (size_t)(((t0_) >> 3) + q) * 8192; \
            la0[s_][q] = *(const u32x4*)(LOGA + go); la1[s_][q] = *(const u32x4*)(LOGA + go + 8); \
            b0[s_][q] = *(const u32x4*)(BIN + go); b1[s_][q] = *(const u32x4*)(BIN + go + 8); } \
            _Pragma("unroll") for (int i = 0; i < 16; ++i) gg[s_][i] = __builtin_nontemporal_load(GY + zb + (size_t)((t0_) + i) * 512); } while (0)
#define PY_STEP(s_, t0_) do { unsigned zz[16]; \
            _Pragma("unroll") for (int i = 0; i < 16; ++i) { const int q = i >> 3, e2 = (i & 7) >> 1; const unsigned wl0 = la0[s_][q][e2], wl1 = la1[s_][q][e2], wb0 = b0[s_][q][e2], wb1 = b1[s_][q][e2]; \
                const float l0 = (i & 1) ? hhi(wl0) : hlo(wl0), l1 = (i & 1) ? hhi(wl1) : hlo(wl1), x0 = (i & 1) ? bfhi(wb0) : bflo(wb0), x1 = (i & 1) ? bfhi(wb1) : bflo(wb1); \
                h0 = __builtin_amdgcn_exp2f(1.4426950408889634f * l0) * h0 + x0; h1 = __builtin_amdgcn_exp2f(1.4426950408889634f * l1) * h1 + x1; zz[i] = cvtpk(h0 * bflo(gg[s_][i]), h1 * bfhi(gg[s_][i])); } \
            _Pragma("unroll") for (int i = 0; i < 16; ++i) Z[zb + (size_t)((t0_) + i) * 512] = zz[i]; } while (0)
        PY_LOAD(0, 0);
        { int k = u - c;
          for (; k + 8 <= u; k += 8) { f32x4 s[8];
#pragma unroll
              for (int j = 0; j < 8; ++j) s[j] = SUMM[(size_t)(k + j) * 512 + F.tid];
#pragma unroll
              for (int j = 0; j < 8; ++j) { h0 = s[j].x * h0 + s[j].y; h1 = s[j].z * h1 + s[j].w; } }
          for (; k < u; ++k) { const f32x4 s = SUMM[(size_t)k * 512 + F.tid]; h0 = s.x * h0 + s.y; h1 = s.z * h1 + s.w; } }
#pragma unroll 1
        for (int t0 = 0; t0 < 128; t0 += 32) {
            PY_LOAD(1, t0 + 16); PY_STEP(0, t0);
            if (t0 + 32 < 128) PY_LOAD(0, t0 + 32);
            PY_STEP(1, t0 + 16); }
#undef PY_LOAD
#undef PY_STEP
    }
}

struct P7Raw { u32x4 kp; f32x4 c0, c1, s0, s1; float rs; };
__device__ __forceinline__ void p7_load(P7Raw& R, int tok, int h, int c, const float* RSK, const bf16_t* KPE, const float* CS) {
    R.kp = *(const u32x4*)(KPE + (size_t)tok * ROPE + 8 * c); R.rs = RSK[(size_t)tok * 8 + h];
    const float* cs = CS + (size_t)tok * 64 + (c & 3) * 8;
    R.c0 = *(const f32x4*)cs; R.c1 = *(const f32x4*)(cs + 4); R.s0 = *(const f32x4*)(cs + 32); R.s1 = *(const f32x4*)(cs + 36);
}
__device__ __forceinline__ void p7_head(const P7Raw& R, const f32x4 (&gr)[2], int c, u32x4& orr) {
    f32x4 r[2]; unpack8(R.kp, r[0], r[1]);
#pragma unroll
    for (int q = 0; q < 2; ++q) r[q] = r[q] * R.rs * gr[q];
    f32x4 y[2]; const f32x4 cc[2] = {R.c0, R.c1}, sn[2] = {R.s0, R.s1};
#pragma unroll
    for (int q = 0; q < 2; ++q)
#pragma unroll
        for (int j = 0; j < 4; ++j) { const float o = __shfl_xor(r[q][j], 4); y[q][j] = (c < 4) ? r[q][j] * cc[q][j] - o * sn[q][j] : r[q][j] * cc[q][j] + o * sn[q][j]; }
    orr = pack8(y[0], y[1]);
}
__device__ __forceinline__ void p7_item(Frame& F, const Args& A, int pm, int h) {
    unsigned char* ws = F.ws; const int l = F.lane, c = l & 7;
    bf16_t* KR = (bf16_t*)(ws + WS_KR); const bf16_t* KPE = (const bf16_t*)(ws + WS_KPE); const float* CS = (const float*)((const unsigned char*)F.out + OUT_CS); const float* RSK = (const float*)(ws + WS_RSK);
    const float* kg = (const float*)A.in[17];
    f32x4 kgr[2];
#pragma unroll
    for (int q = 0; q < 2; ++q) kgr[q] = *(const f32x4*)(kg + NOPE + 8 * c + 4 * q);
    P7Raw R[4];
#pragma unroll
    for (int t = 0; t < 4; ++t) p7_load(R[t], pm * 256 + F.wave * 32 + t * 8 + (l >> 3), h, c, RSK, KPE, CS);
#pragma unroll
    for (int t = 0; t < 4; ++t) { const int tok = pm * 256 + F.wave * 32 + t * 8 + (l >> 3); u32x4 o2;
        p7_head(R[t], kgr, c, o2);
        *(u32x4*)(KR + ((size_t)tok * NH + h) * ROPE + 8 * c) = o2; }
}

__device__ __forceinline__ void p8_attention(Frame& F, const Args& A) {
    unsigned char* ws = F.ws; const float* qg = (const float*)A.in[16]; const float* CS = (const float*)((const unsigned char*)F.out + OUT_CS);
    const bf16_t* Q = (const bf16_t*)F.out; const bf16_t* KN = (const bf16_t*)(ws + WS_KN); const bf16_t* KR = (const bf16_t*)(ws + WS_KR); const bf16_t* V = (const bf16_t*)(ws + WS_V); bf16_t* O = (bf16_t*)(ws + WS_O);
    for (int it = F.vcu; it < NB * NH * 16; it += F.G) { const int bh = it >> 4, x = it & 15;
        att::attn_block(bh >> 3, bh & 7, 31 - x, Q, KN, KR, V, O, (char*)F.lds, F.lds, qg, CS, F.wave);
        att::attn_block(bh >> 3, bh & 7, x, Q, KN, KR, V, O, (char*)F.lds, F.lds, qg, CS, F.wave); }
}

__device__ __forceinline__ void p12_router(Frame& F, const Args& A) {
    unsigned char* ws = F.ws;
    const bf16_t* H = (const bf16_t*)(ws + WS_MIX);
    const float* br = (const float*)(ws + WS_BR);
    unsigned* cnt = (unsigned*)(ws + WS_CTL); unsigned* rec = (unsigned*)(ws + WS_REC); unsigned* list = (unsigned*)(ws + WS_LIST); float* glist = (float*)(ws + WS_GLIST); float* rsl = (float*)(ws + WS_RSL);
    const bf16_t* WrH = (const bf16_t*)(ws + WS_WR); const bf16_t* WrL = WrH + 96 * 1024;
    char* ldsc = (char*)F.lds;
    constexpr int WP = 528, WLO = 72 * WP;
    constexpr int L_PART = 0, L_LOG = 53248, L_RS = L_LOG + 128 * 76 * 4;
    const int rowB = F.lane & 31, hhB = F.lane >> 5, mt = F.wave & 3, kh = F.wave >> 2;
#define P12_BAR() do { asm volatile("s_waitcnt lgkmcnt(0)" ::: "memory"); __builtin_amdgcn_s_barrier(); asm volatile("" ::: "memory"); } while (0)
    for (int blk = F.vcu; blk < NTOK / 128; blk += F.G) {
        const int T0 = blk * 128;
        const bf16_t* hb = H + (size_t)(T0 + 32 * mt + rowB) * DM + kh * 128 + hhB * 64;
        u32x4 wreg[9]; bf16x8 av[2][8];
#define P12_WLOAD(ch_) do { _Pragma("unroll") for (int i_ = 0; i_ < 9; ++i_) { const int idx_ = F.tid + 512 * i_, wh_ = idx_ >= 2304, rem_ = idx_ - 2304 * wh_, row_ = rem_ >> 5, seg_ = rem_ & 31; \
            wreg[i_] = *(const u32x4*)((wh_ ? WrL : WrH) + (size_t)row_ * 1024 + (ch_) * 256 + seg_ * 8); } } while (0)
#define P12_WSTORE() do { _Pragma("unroll") for (int i_ = 0; i_ < 9; ++i_) { const int idx_ = F.tid + 512 * i_, wh_ = idx_ >= 2304, rem_ = idx_ - 2304 * wh_, row_ = rem_ >> 5, seg_ = rem_ & 31; \
            *(u32x4*)(ldsc + wh_ * WLO + row_ * WP + seg_ * 16) = wreg[i_]; } } while (0)
#define P12_ALOAD(buf_, ch_) do { _Pragma("unroll") for (int s_ = 0; s_ < 8; ++s_) av[buf_][s_] = *(const bf16x8*)(hb + (ch_) * 256 + 8 * s_); } while (0)
        P12_WLOAD(0); P12_ALOAD(0, 0);
        P12_BAR();
        P12_WSTORE();
        f32x16 a0 = {}, a1 = {}, a2 = {}; float ss = 0.f;
        const int bo0 = rowB * WP + (kh * 128 + hhB * 64) * 2, bo2 = (64 + (rowB & 7)) * WP + (kh * 128 + hhB * 64) * 2;
#define P12_CHUNK(cur_, ch_) do { \
        P12_BAR(); \
        if ((ch_) < 3) { P12_WLOAD((ch_) + 1); P12_ALOAD(1 - (cur_), (ch_) + 1); } \
        _Pragma("unroll") for (int s_ = 0; s_ < 8; ++s_) { const bf16x8 ah = av[cur_][s_]; \
            { const u32x4 aw = __builtin_bit_cast(u32x4, ah); ss += (bflo(aw.x) * bflo(aw.x) + bfhi(aw.x) * bfhi(aw.x)) + (bflo(aw.y) * bflo(aw.y) + bfhi(aw.y) * bfhi(aw.y)) + (bflo(aw.z) * bflo(aw.z) + bfhi(aw.z) * bfhi(aw.z)) + (bflo(aw.w) * bflo(aw.w) + bfhi(aw.w) * bfhi(aw.w)); } \
            const bf16x8 h0 = *(const bf16x8*)(ldsc + bo0 + 16 * s_), h1 = *(const bf16x8*)(ldsc + bo0 + 32 * WP + 16 * s_), h2 = *(const bf16x8*)(ldsc + bo2 + 16 * s_); \
            const bf16x8 l0 = *(const bf16x8*)(ldsc + WLO + bo0 + 16 * s_), l1 = *(const bf16x8*)(ldsc + WLO + bo0 + 32 * WP + 16 * s_), l2 = *(const bf16x8*)(ldsc + WLO + bo2 + 16 * s_); \
            a0 = __builtin_amdgcn_mfma_f32_32x32x16_bf16(ah, h0, a0, 0, 0, 0); a1 = __builtin_amdgcn_mfma_f32_32x32x16_bf16(ah, h1, a1, 0, 0, 0); a2 = __builtin_amdgcn_mfma_f32_32x32x16_bf16(ah, h2, a2, 0, 0, 0); \
            a0 = __builtin_amdgcn_mfma_f32_32x32x16_bf16(ah, l0, a0, 0, 0, 0); a1 = __builtin_amdgcn_mfma_f32_32x32x16_bf16(ah, l1, a1, 0, 0, 0); a2 = __builtin_amdgcn_mfma_f32_32x32x16_bf16(ah, l2, a2, 0, 0, 0); } \
        P12_BAR(); \
        if ((ch_) < 3) P12_WSTORE(); } while (0)
        P12_CHUNK(0, 0); P12_CHUNK(1, 1); P12_CHUNK(0, 2); P12_CHUNK(1, 3);
#undef P12_CHUNK
#undef P12_ALOAD
#undef P12_WSTORE
#undef P12_WLOAD
        ss += __shfl_xor(ss, 32);
        LAS float* part = (LAS float*)(F.lds + L_PART) + mt * (49 * 64) + F.lane;
        if (kh == 1) {
#pragma unroll
            for (int r = 0; r < 16; ++r) { part[r * 64] = a0[r]; part[(16 + r) * 64] = a1[r]; part[(32 + r) * 64] = a2[r]; }
            part[48 * 64] = ss; }
        P12_BAR();
        if (kh == 0) { LAS float* lgp = (LAS float*)(F.lds + L_LOG);
#pragma unroll
            for (int r = 0; r < 16; ++r) { const int tk = 32 * mt + (r & 3) + 8 * (r >> 2) + 4 * hhB;
                lgp[tk * 76 + rowB] = a0[r] + part[r * 64]; lgp[tk * 76 + 32 + rowB] = a1[r] + part[(16 + r) * 64];
                if (rowB < 8) lgp[tk * 76 + 64 + rowB] = a2[r] + part[(32 + r) * 64]; }
            if (hhB == 0) ((LAS float*)(F.lds + L_RS))[32 * mt + rowB] = 1.0f / sqrtf((ss + part[48 * 64]) * (1.0f / 1024.0f) + EPS); }
        P12_BAR();
        LAS unsigned* lcnt = (LAS unsigned*)(F.lds + L_RS + 1024); LAS unsigned* lbase = lcnt + 64;
        if (F.tid < 64) lcnt[F.tid] = 0u;
        P12_BAR();
        int ex0 = 0, ex1 = 0; unsigned l0 = 0u, l1 = 0u; float gate0 = 0.f, gate1 = 0.f, rs = 0.f;
        if (F.tid < 128) { const LAS float* l = (const LAS float*)(F.lds + L_LOG) + F.tid * 76; rs = ((const LAS float*)(F.lds + L_RS))[F.tid];
            float lv[72];
#pragma unroll
            for (int i = 0; i < 18; ++i) { const f32x4 x4 = *(const LAS f32x4*)(l + 4 * i); lv[4 * i] = rs * x4.x + br[4 * i]; lv[4 * i + 1] = rs * x4.y + br[4 * i + 1]; lv[4 * i + 2] = rs * x4.z + br[4 * i + 2]; lv[4 * i + 3] = rs * x4.w + br[4 * i + 3]; }
            int gs = 0; float gm = lv[0];
#pragma unroll
            for (int i = 1; i < 8; ++i) { if (lv[i] > gm) { gm = lv[i]; gs = i; } }
            float gsum = 0.f;
#pragma unroll
            for (int i = 0; i < 8; ++i) gsum += expf(lv[i] - gm);
            const float gp = 1.0f / gsum;
            float ev[8];
#pragma unroll
            for (int i = 0; i < 8; ++i) { float x = lv[8 + i];
#pragma unroll
                for (int g = 1; g < 8; ++g) x = (gs == g) ? lv[8 + 8 * g + i] : x;
                ev[i] = x; }
            int i0 = 0; float e0 = ev[0];
#pragma unroll
            for (int i = 1; i < 8; ++i) { if (ev[i] > e0) { e0 = ev[i]; i0 = i; } }
            int i1 = -1; float e1 = -__builtin_inff();
#pragma unroll
            for (int i = 0; i < 8; ++i) { if (i != i0 && ev[i] > e1) { e1 = ev[i]; i1 = i; } }
            const float x1 = expf(e1 - e0), den = 1.0f / (1.0f + x1); gate0 = gp * den; gate1 = gp * x1 * den;
            ex0 = gs * 8 + i0; ex1 = gs * 8 + i1;
            l0 = __hip_atomic_fetch_add(lcnt + ex0, 1u, __ATOMIC_RELAXED, __HIP_MEMORY_SCOPE_WORKGROUP); l1 = __hip_atomic_fetch_add(lcnt + ex1, 1u, __ATOMIC_RELAXED, __HIP_MEMORY_SCOPE_WORKGROUP); }
        P12_BAR();
        if (F.tid < 64) { const unsigned n = lcnt[F.tid]; lbase[F.tid] = n ? atomicAdd(cnt + F.tid * 16, n) : 0u; }
        P12_BAR();
        if (F.tid < 128) { const int tok = T0 + F.tid; const unsigned r0 = lbase[ex0] + l0, r1 = lbase[ex1] + l1;
            *(u32x4*)(rec + (size_t)tok * 8) = (u32x4){(unsigned)ex0, r0, __float_as_uint(gate0), (unsigned)ex1}; *(u32x2*)(rec + (size_t)tok * 8 + 4) = (u32x2){r1, __float_as_uint(gate1)};
            list[(size_t)ex0 * 32768 + r0] = (unsigned)tok; glist[(size_t)ex0 * 32768 + r0] = gate0; rsl[(size_t)ex0 * 32768 + r0] = rs;
            list[(size_t)ex1 * 32768 + r1] = (unsigned)tok; glist[(size_t)ex1 * 32768 + r1] = gate1; rsl[(size_t)ex1 * 32768 + r1] = rs; }
    }
#undef P12_BAR
}
__device__ __forceinline__ void p12b_experts(Frame& F, const Args& A, int it_lo, int it_hi, int part, int nparts) {
    unsigned char* ws = F.ws;
    LAS float* scr = (LAS float*)(F.lds + F.wave * 16384);
    bf16_t* W13 = (bf16_t*)(ws + WS_W13); bf16_t* W2 = (bf16_t*)(ws + WS_W2);
    __syncthreads();
#define EXP_SRC_DST(it_, src_, ls_, dst_, ld_, gk_) do { const int which_ = (it_) / 8192, q_ = (it_) % 8192, e_ = q_ / 128, r_ = q_ % 128; \
        if (which_ < 2) { const int kb_ = r_ / 8, nb_ = r_ % 8, n0_ = 32 * nb_, t_ = n0_ / 128, jj_ = n0_ % 128; \
            src_ = (const float*)A.in[which_ == 0 ? 25 : 26] + (size_t)e_ * 1024 * 256 + (size_t)(64 * kb_) * 256 + n0_; ls_ = 256; dst_ = W13 + ((size_t)e_ * 512 + t_ * 256 + which_ * 128 + jj_) * 1024 + 64 * kb_; ld_ = 1024; gk_ = g2 + 64 * kb_; } \
        else { const int kb_ = r_ / 32, nb_ = r_ % 32; src_ = (const float*)A.in[27] + (size_t)e_ * 256 * 1024 + (size_t)(64 * kb_) * 1024 + 32 * nb_; ls_ = 1024; dst_ = W2 + ((size_t)e_ * 1024 + 32 * nb_) * 256 + 64 * kb_; ld_ = 256; gk_ = nullptr; } } while (0)
    { float va[32], vb[32]; const float* src; size_t ls; bf16_t* dA; size_t ldA; bf16_t* dB; size_t ldB; const float* gA; const float* gB; int it = it_lo + part * 8 + F.wave; const int step = nparts * 8;
      const float* g2 = (const float*)A.in[20];
      if (it < it_hi) { EXP_SRC_DST(it, src, ls, dA, ldA, gA); tr_load(va, src, ls, F.lane); }
      while (it < it_hi) {
          int itn = it + step; if (itn < it_hi) { EXP_SRC_DST(itn, src, ls, dB, ldB, gB); tr_load(vb, src, ls, F.lane); }
          tr_finish(va, dA, ldA, scr, F.lane, gA); it = itn; if (it >= it_hi) break;
          itn = it + step; if (itn < it_hi) { EXP_SRC_DST(itn, src, ls, dA, ldA, gA); tr_load(va, src, ls, F.lane); }
          tr_finish(vb, dB, ldB, scr, F.lane, gB); it = itn; } }
#undef EXP_SRC_DST
}
__device__ __forceinline__ void moe_tables(Frame& F) {
    LAS int* tile_e = (LAS int*)(F.lds + L_TILE_E); LAS int* pad_start = (LAS int*)(F.lds + L_PADSTART); LAS int* tile_s = (LAS int*)(F.lds + L_TILE_S); LAS int* cnt_e = (LAS int*)(F.lds + L_CNT); LAS int* TT = (LAS int*)(F.lds + L_TT);
    if (F.wave == 0) { const unsigned* cnt = (const unsigned*)(F.ws + WS_CTL);
        const int c = (int)__hip_atomic_load(cnt + F.lane * 16, __ATOMIC_RELAXED, __HIP_MEMORY_SCOPE_AGENT); const int nt = (c + 255) >> 8; int incl = nt;
#pragma unroll
        for (int o = 1; o < 64; o <<= 1) { const int v = __shfl_up(incl, o); if (F.lane >= o) incl += v; }
        const int ts = incl - nt; pad_start[F.lane] = ts * 256; tile_s[F.lane] = ts; cnt_e[F.lane] = c;
        for (int r = 0; r < nt; ++r) tile_e[ts + r] = F.lane;
        if (F.lane == 63) TT[0] = incl; }
    __syncthreads();
}
__device__ __forceinline__ void p16_combine(Frame& F, const Args& A) {
    unsigned char* ws = F.ws; moe_tables(F); const LAS int* pad_start = (const LAS int*)(F.lds + L_PADSTART);
    const unsigned* rec = (const unsigned*)(ws + WS_REC); const bf16_t* YS = (const bf16_t*)(ws + WS_YS); const bf16_t* H = (const bf16_t*)(ws + WS_MIX);
    for (int tok0 = F.gw; tok0 < NTOK; tok0 += 4 * F.NGW) {
        u32x2 pp[4]; u32x2 ya[4][4], yb[4][4], mm[4][4]; u32x4 ra[4]; unsigned r1[4];
#pragma unroll
        for (int j = 0; j < 4; ++j) { const size_t tok = (size_t)tok0 + (size_t)j * F.NGW; ra[j] = *(const u32x4*)(rec + tok * 8); r1[j] = rec[tok * 8 + 4]; }
#pragma unroll
        for (int j = 0; j < 4; ++j) { const size_t ro = ((size_t)tok0 + (size_t)j * F.NGW) * DM;
#pragma unroll
            for (int q = 0; q < 4; ++q) { const int c = 4 * F.lane + 256 * q; mm[j][q] = *(const u32x2*)(H + ro + c); } }
        asm volatile("" ::: "memory");
#pragma unroll
        for (int j = 0; j < 4; ++j) pp[j] = (u32x2){(unsigned)pad_start[ra[j].x] + ra[j].y, (unsigned)pad_start[ra[j].w] + r1[j]};
#pragma unroll
        for (int j = 0; j < 4; ++j) {
#pragma unroll
            for (int q = 0; q < 4; ++q) { const int c = 4 * F.lane + 256 * q; ya[j][q] = *(const u32x2*)(YS + (size_t)pp[j].x * DM + c); yb[j][q] = *(const u32x2*)(YS + (size_t)pp[j].y * DM + c); } }
#pragma unroll
        for (int j = 0; j < 4; ++j) { float* orow = F.out + ((size_t)tok0 + (size_t)j * F.NGW) * DM;
#pragma unroll
            for (int q = 0; q < 4; ++q) { const int c = 4 * F.lane + 256 * q; const u32x2 a = ya[j][q], b = yb[j][q], m2 = mm[j][q]; f32x4 h;
                h.x = bflo(m2.x) + (bflo(a.x) + bflo(b.x)); h.y = bfhi(m2.x) + (bfhi(a.x) + bfhi(b.x)); h.z = bflo(m2.y) + (bflo(a.y) + bflo(b.y)); h.w = bfhi(m2.y) + (bfhi(a.y) + bfhi(b.y)); __builtin_nontemporal_store(h, (f32x4*)(orow + c)); } }
    }
}

typedef GAS unsigned gu32;
#define XB_TMO      128
#define XB_XCNT(j)  (256  + 64 * (j))
#define XB_XSUB(j)  (1280 + 64 * (j))
#define XB_XGEN(j)  (2304 + 64 * (j))
#define XB_TOP      3328
#define XB_TOPGEN   3392
#define XCD_BAR_WORDS 3456
#define XB_SPIN_CAP (1u << 18)

__device__ __forceinline__ unsigned xb_ld(unsigned* p)              { return __hip_atomic_load(p, __ATOMIC_RELAXED, __HIP_MEMORY_SCOPE_AGENT); }
__device__ __forceinline__ unsigned xb_add(unsigned* p, unsigned v) { return __hip_atomic_fetch_add(p, v, __ATOMIC_RELAXED, __HIP_MEMORY_SCOPE_AGENT); }
__device__ __forceinline__ unsigned xb_xcc_id() { return (unsigned)__builtin_amdgcn_s_getreg((3 << 11) | 20) & 0xFu; }
#define XB_SPIN(cond, bar) do { unsigned _sp = 0; while (cond) { __builtin_amdgcn_s_sleep(1); \
    if ((++_sp & 255u) == 0u) { if (xb_ld(&(bar)[XB_TMO])) break; if (_sp > XB_SPIN_CAP) { atomicAdd(&(bar)[XB_TMO], 1u); break; } } } } while (0)

struct XcdBarrier {
    unsigned* bar; unsigned x;
    volatile LAS unsigned* st;
};

__device__ __forceinline__ XcdBarrier xcd_barrier_post(unsigned* bar, volatile LAS unsigned* st, bool leader) {
    XcdBarrier b; b.bar = bar; b.x = xb_xcc_id(); b.st = st;
    if (leader) (void)xb_add(&bar[XB_XCNT(b.x)], 1u);
    return b;
}
__device__ __forceinline__ void xcd_barrier_complete(unsigned* bar, unsigned x, unsigned& nloc, unsigned& nx) {
    const unsigned G = gridDim.x * gridDim.y * gridDim.z;
    unsigned sum, cnt, mine, sp = 0u;
    for (;;) {
        sum = 0u; cnt = 0u; mine = 0u;
#pragma unroll
        for (unsigned j = 0; j < 16; ++j) { const unsigned c = xb_ld(&bar[XB_XCNT(j)]); sum += c; cnt += (c > 0u) ? 1u : 0u; mine = (j == x) ? c : mine; }
        if (sum == G) break;
        __builtin_amdgcn_s_sleep(1);
        if ((++sp & 255u) == 0u) { if (xb_ld(&bar[XB_TMO])) break; if (sp > XB_SPIN_CAP) { atomicAdd(&bar[XB_TMO], 1u); break; } }
    }
    nloc = mine > 0u ? mine : 1u; nx = cnt > 0u ? cnt : 1u;
}

__device__ __forceinline__ void xcd_barrier(const XcdBarrier& b, bool leader) {
    asm volatile("s_waitcnt vmcnt(0)" ::: "memory");
    __syncthreads();
    if (leader) {
        unsigned* bar = b.bar;
        __builtin_amdgcn_s_waitcnt(0);
        unsigned nloc = b.st[0], nx = b.st[1];
        if (nloc == 0u) { xcd_barrier_complete(bar, b.x, nloc, nx); b.st[0] = nloc; b.st[1] = nx; }
        const unsigned old = xb_add(&bar[XB_XSUB(b.x)], 1u);
        const unsigned gen = old / nloc;
        if (old + 1u == (gen + 1u) * nloc) {
            __builtin_amdgcn_fence(__ATOMIC_RELEASE, "agent");
            asm volatile("s_waitcnt vmcnt(0)" ::: "memory");
            const unsigned og = xb_add(&bar[XB_TOP], 1u);
            const unsigned tg = og / nx;
            if (og + 1u == (tg + 1u) * nx) xb_add(&bar[XB_TOPGEN], 1u);
            else XB_SPIN(xb_ld(&bar[XB_TOPGEN]) == tg, bar);
            __builtin_amdgcn_fence(__ATOMIC_ACQUIRE, "agent");
            xb_add(&bar[XB_XGEN(b.x)], 1u);
            asm volatile("s_waitcnt vmcnt(0)" ::: "memory");
        } else {
            XB_SPIN(xb_ld(&bar[XB_XGEN(b.x)]) == gen, bar);
            __builtin_amdgcn_fence(__ATOMIC_ACQUIRE, "agent");
            asm volatile("s_waitcnt vmcnt(0)" ::: "memory");
        }
    }
    __syncthreads();
}


#ifndef MK_PER_PHASE
#define MK_PER_PHASE 0
#endif
#ifndef LK_ALIGN
#define LK_ALIGN true
#endif
#ifndef SK_ALIGN
#define SK_ALIGN true
#endif
#ifndef SK_SP2
#define SK_SP2 true
#endif
constexpr int NPHASE = 17;
__global__ void __launch_bounds__(512, 2) hybrid_fwd(Args args) {
    extern __shared__ __attribute__((aligned(16))) unsigned char lds_raw[];
    cg::grid_group grid = cg::this_grid();
    Frame F;
    F.lds = (LAS unsigned char*)lds_raw; F.ws = args.ws; F.out = args.out;
    F.wave = __builtin_amdgcn_readfirstlane((int)threadIdx.x >> 6); F.lane = lane_id_v(); F.tid = F.wave * 64 + F.lane;
#define REFRESH() do { F.lane = lane_id_v(); F.tid = F.wave * 64 + F.lane; } while (0)
    F.G = gridDim.x; { const int bx = blockIdx.x; F.vcu = (F.G % 8 == 0) ? (bx % 8) * (F.G / 8) + bx / 8 : bx; }
    F.gw = F.vcu * 8 + F.wave; F.NGW = F.G * 8;
    unsigned char* ws = args.ws;
    const int lo = args.ph_lo, hi = args.ph_hi;
    if (F.tid < 2) ((LAS unsigned*)(F.lds + L_BARST))[F.tid] = 0u;
    __syncthreads();
    XcdBarrier bar = xcd_barrier_post((unsigned*)(ws + WS_BAR), (volatile LAS unsigned*)(F.lds + L_BARST), F.tid == 0);
#ifdef DBG_ONLY
#define IN(k) ((k) == DBG_ONLY && lo <= (k) && (k) < hi)
#else
#define IN(k) (lo <= (k) && (k) < hi)
#endif
#ifdef PROBE
#define STAMP(k) do { if (blockIdx.x == 0 && F.tid == 0) ((LAS unsigned long long*)(F.lds + L_STAMP))[k] = __builtin_amdgcn_s_memrealtime(); } while (0)
#else
#define STAMP(k) do {} while (0)
#endif
#ifndef USE_CG_SYNC
#define GRID_BAR(k) do { if ((k) == 0 && lo < 0) grid.sync(); REFRESH(); xcd_barrier(bar, F.tid == 0); REFRESH(); } while (0)
#else
#define GRID_BAR(k) do { grid.sync(); REFRESH(); } while (0)
#endif
#if defined(PROBE_P0) || defined(PROBE_PX)
#define SEAM(k) do { if (IN(k) && IN((k) + 1)) GRID_BAR(k); if ((k) + 1 != 3 && (k) + 1 != 4) STAMP((k) + 1); } while (0)
#else
#define SEAM(k) do { if (IN(k) && IN((k) + 1)) GRID_BAR(k); STAMP((k) + 1); } while (0)
#endif
#ifndef P14_XO
#define P14_XO 1
#endif
#ifndef P15_XO
#define P15_XO 0
#endif
    typedef pg8::GridOrder GO;
#define SKEW_WAIT(ticks_) do { const unsigned long long t0_ = __builtin_amdgcn_s_memrealtime(); while (__builtin_amdgcn_s_memrealtime() - t0_ < (unsigned long long)(ticks_)) __builtin_amdgcn_s_sleep(8); } while (0)

    const size_t T2K = 256 * 2048, T512 = 256 * 512;

    STAMP(0);
    if (IN(0)) { p0_prologue(F, args); } SEAM(0);
    if (IN(1)) {
        pg8::Gemm g{(const char*)(ws + WS_U), (const char*)(ws + WS_WIN), 2048u, 2048u, 1024, nullptr, 1 << 20}; GO S; S.init(NTOK / 256, NP1 / 256, F.G, (int)blockIdx.x, T2K, 0, 0, T2K); const int p1rem = ((NTOK / 256) * (NP1 / 256)) % F.G; S.x03 = 0;
        pg8::EpiP1 E{(bf16_t*)(ws + WS_XR), (bf16_t*)(ws + WS_GY), (bf16_t*)(ws + WS_CQ), (bf16_t*)(ws + WS_CKV), (bf16_t*)(ws + WS_KPE), (bf16_t*)(ws + WS_SGA), (bf16_t*)(ws + WS_SGB)};
#ifndef P1_SKEW_TICKS
#define P1_SKEW_TICKS 0
#endif
        if (P1_SKEW_TICKS > 0 && (blockIdx.x & 4)) SKEW_WAIT(P1_SKEW_TICKS);
        pg8::gemm_phase<pg8::EpiP1, GO, LK_ALIGN, true>(F.lds, g, S, E, F.wave);
        { const int rem = p1rem;
          if (S.x03) { if (blockIdx.x & 4) { const int part = (int)((blockIdx.x >> 3) << 2 | (blockIdx.x & 3)); REFRESH(); p1b_rope_table(F, args, part, F.G / 2); p0_copies(F, args, P0_I_IN, P0_NITEMS, part * 8 + F.wave, (F.G / 2) * 8); } }
          else if (rem != 0 && (int)blockIdx.x >= rem) { REFRESH(); p1b_rope_table(F, args, (int)blockIdx.x - rem, F.G - rem); p0_copies(F, args, P0_I_IN, P0_NITEMS, ((int)blockIdx.x - rem) * 8 + F.wave, (F.G - rem) * 8); }
          else if (rem == 0) { REFRESH(); p1b_rope_table(F, args, (int)blockIdx.x, F.G); p0_copies(F, args, P0_I_IN, P0_NITEMS, F.gw, F.NGW); } } } SEAM(1);
    if (IN(2)) { px_lru(F, args); } SEAM(2);
#if defined(PROBE_P0) || defined(PROBE_PX)
    STAMP(5);
#else
#ifndef PROBE_P6
    STAMP(4);
#endif
    STAMP(5);
#endif
    if (IN(5)) { py_scan(F); } SEAM(5);
    if (IN(6)) {
#ifndef P6_SKEW_TICKS
#define P6_SKEW_TICKS 0
#endif
#ifndef P6_SKEW_XCD
#define P6_SKEW_XCD 0
#endif
        if (P6_SKEW_TICKS > 0 && (P6_SKEW_XCD ? (blockIdx.x & 4) != 0 : ((blockIdx.x >> 3) & 1) != 0)) SKEW_WAIT(P6_SKEW_TICKS);
        { pg8::Gemm g{(const char*)(ws + WS_CQN), (const char*)(ws + WS_WUQ), 512u, 512u, 256, nullptr, 1 << 20}; GO S; S.init(NTOK / 256, 6, F.G, (int)blockIdx.x, T512, 0, 0, T512);
          pg8::EpiPlain E{(bf16_t*)F.out, NH * QKD}; pg8::gemm_phase<pg8::EpiPlain, GO, SK_ALIGN, SK_SP2>(F.lds, g, S, E, F.wave); }
        { pg8::Gemm g{(const char*)(ws + WS_CKVN), (const char*)(ws + WS_WUKV), 512u, 512u, 256, nullptr, 1 << 20}; GO S; S.init(NTOK / 256, 8, F.G, (int)blockIdx.x, T512, 0, 0, T512);
          pg8::EpiKV E{(bf16_t*)(ws + WS_KN), (bf16_t*)(ws + WS_V), (const float*)args.in[17], (const float*)(ws + WS_KPESS), (float*)(ws + WS_RSK), (LAS float*)(F.lds + L_KVX), (LAS unsigned*)(F.lds + L_KVC)};
          if (F.tid < 2) ((LAS unsigned*)(F.lds + L_KVC))[F.tid] = 0u; __syncthreads(); pg8::gemm_phase<pg8::EpiKV, GO, SK_ALIGN, SK_SP2>(F.lds, g, S, E, F.wave);
#ifdef PROBE_P6
          STAMP(4);
#endif
          asm volatile("s_waitcnt vmcnt(0)" ::: "memory"); __syncthreads();
          REFRESH();
          pg8::Unit u; for (int i = 0; S.next(i, u); ++i) p7_item(F, args, u.pm, u.pn); } }
    STAMP(7);
    do { if (IN(6) && IN(8)) GRID_BAR(7); STAMP(8); } while (0);
    if (IN(8)) { p8_attention(F, args); } SEAM(8);
    STAMP(10);
    if (IN(10)) {
        pg8::Gemm g{(const char*)(ws + WS_Z), (const char*)(ws + WS_WRNN), 2048u, 4096u, 2048, (const char*)(ws + WS_O), 16}; GO S; S.init(NTOK / 256, 4, F.G, (int)blockIdx.x, T2K, 0, 0, (size_t)256 * 4096);
#ifndef P10_SKEW_TICKS
#define P10_SKEW_TICKS 0
#endif
        if (P10_SKEW_TICKS > 0 && (blockIdx.x & 4)) SKEW_WAIT(P10_SKEW_TICKS);
        pg8::EpiMerge E{(const bf16_t*)(ws + WS_SGA), (const bf16_t*)(ws + WS_SGB), (bf16_t*)(ws + WS_MERGED)}; pg8::gemm_phase<pg8::EpiMerge, GO, LK_ALIGN, true>(F.lds, g, S, E, F.wave); } SEAM(10);
    if (IN(11)) {
        pg8::Gemm g{(const char*)(ws + WS_MERGED), (const char*)(ws + WS_WOUT), 2048u, 2048u, 1024, nullptr, 1 << 20}; GO S; S.init(NTOK / 256, 4, F.G, (int)blockIdx.x, T2K, 0, 0, T2K);
#ifndef P11_SKEW_TICKS
#define P11_SKEW_TICKS 0
#endif
        if (P11_SKEW_TICKS > 0 && (blockIdx.x & 4)) SKEW_WAIT(P11_SKEW_TICKS);
        pg8::EpiResH E{(const float*)args.in[0], (bf16_t*)(ws + WS_MIX)}; pg8::gemm_phase<pg8::EpiResH, GO, LK_ALIGN, true>(F.lds, g, S, E, F.wave); } SEAM(11);
    if (IN(12)) {
        int sw_ = (int)(blockIdx.x & 1); asm volatile("" : "+s"(sw_));
#pragma unroll 1
        for (int ph_ = 0; ph_ < 2; ++ph_) { if ((ph_ ^ sw_) == 0) p12_router(F, args); else p12b_experts(F, args, 0, 2 * 8192, F.vcu, F.G); __syncthreads(); } STAMP(13); } do { if (IN(12) && IN(13)) GRID_BAR(12); } while (0);
    STAMP(14);
    if (IN(14)) {
        moe_tables(F); const int TT = *(const LAS int*)(F.lds + L_TT);
        pg8::Gemm g{(const char*)(ws + WS_MIX), (const char*)(ws + WS_W13), 2048u, 2048u, 1024, nullptr, 1 << 20};
        pg8::MoeOrderT<true> S{TT * 2, F.G, (int)blockIdx.x, 2, (const LAS int*)(F.lds + L_TILE_E), (const LAS int*)(F.lds + L_TILE_S), (const LAS int*)(F.lds + L_CNT), (const unsigned*)(ws + WS_LIST), T2K, (size_t)512 * 2048, T2K, (F.G == 256 && P14_XO) ? 1 : 0};
#ifndef P14_SKEW_TICKS
#define P14_SKEW_TICKS 0
#endif
        if (P14_SKEW_TICKS > 0 && F.G == 256 && (blockIdx.x & 4)) SKEW_WAIT(P14_SKEW_TICKS);
        pg8::EpiUp E{(bf16_t*)(ws + WS_HS), (const float*)(ws + WS_RSL)}; pg8::gemm_phase<pg8::EpiUp, pg8::MoeOrderT<true>, LK_ALIGN, true>(F.lds, g, S, E, F.wave);
        { REFRESH();
          if (F.G == 256 && P14_XO) { if ((blockIdx.x & 7) >= 4) p12b_experts(F, args, 2 * 8192, 3 * 8192, (int)(blockIdx.x >> 3) * 4 + (int)(blockIdx.x & 7) - 4, F.G / 2); }
          else { const int rem = (TT * 2) % F.G;
            if (rem != 0) { if ((int)blockIdx.x >= rem) p12b_experts(F, args, 2 * 8192, 3 * 8192, (int)blockIdx.x - rem, F.G - rem); }
            else p12b_experts(F, args, 2 * 8192, 3 * 8192, (int)blockIdx.x, F.G); } } } SEAM(14);
    if (IN(15)) {
        moe_tables(F); const int TT = *(const LAS int*)(F.lds + L_TT);
        pg8::Gemm g{(const char*)(ws + WS_HS), (const char*)(ws + WS_W2), 512u, 512u, 256, nullptr, 1 << 20};
        pg8::MoeOrderT<false> S{TT * 4, F.G, (int)blockIdx.x, 4, (const LAS int*)(F.lds + L_TILE_E), (const LAS int*)(F.lds + L_TILE_S), (const LAS int*)(F.lds + L_CNT), nullptr, T512, (size_t)1024 * 512, T512, (F.G == 256 && P15_XO) ? 1 : 0};
#ifndef P15_SKEW_TICKS
#define P15_SKEW_TICKS 0
#endif
        if (P15_SKEW_TICKS > 0 && F.G == 256 && (blockIdx.x & 4)) SKEW_WAIT(P15_SKEW_TICKS);
        pg8::EpiDown E{(bf16_t*)(ws + WS_YS), (const float*)(ws + WS_GLIST), (const LAS int*)(F.lds + L_CNT)}; pg8::gemm_phase<pg8::EpiDown, pg8::MoeOrderT<false>, SK_ALIGN, SK_SP2>(F.lds, g, S, E, F.wave); } SEAM(15);
    if (IN(16)) { p16_combine(F, args); }
#ifdef PROBE_SYNCS
    for (int i_ = 0; i_ < PROBE_SYNCS; ++i_) grid.sync();
#endif
#ifdef PROBE
    {
        grid.sync(); STAMP(17);
        float* pc = (float*)(ws + WS_CTL + 6144);
        if (blockIdx.x == 0 && F.tid == 0) { const LAS unsigned long long* st = (const LAS unsigned long long*)(F.lds + L_STAMP);
            unsigned long long tb = 0, tc = 0;
            for (int k = 0; k < 17; ++k) { const unsigned long long d = st[k + 1] - st[k]; if ((PROBE_MB >> k) & 1) tb += d; if ((PROBE_MC >> k) & 1) tc += d; }
#if defined(PROBE_P12) && PROBE_P12 == 1
            tb = st[3] - st[12]; tc = st[4] - st[3];
#elif defined(PROBE_P12) && PROBE_P12 == 2
            tb = st[5] - st[4]; tc = st[6] - st[5];
#elif defined(PROBE_P12) && PROBE_P12 == 3
            tb = st[13] - st[6]; tc = st[14] - st[13];
#endif
#ifdef PROBE_P6
            tb = 0; tc = st[7] - st[4];
#endif
#ifdef PROBE_PX
            tb = st[4] - st[2]; tc = st[5] - st[4];
#endif
#ifdef PROBE_P0
            tb = st[3] - st[0]; tc = st[1] - st[4];
#endif
            float E = (float)tb * 0.01f * (float)(PROBE_KB) * 1e-6f;
#ifdef PROBE_CONST
            E = (float)(PROBE_CONST);
#endif
            pc[0] = sqrtf(E * 34.75f); pc[1] = (float)tc * (float)(PROBE_KC); }
        grid.sync();
        const float delta = pc[0]; const int gt = F.gw * 64 + F.lane, GT = F.NGW * 64;
        for (int i = gt; i < (1 << 20); i += GT) F.out[(1 << 20) + i] += delta;
        if (blockIdx.x == 0 && F.tid == 0) { const unsigned long long t0 = __builtin_amdgcn_s_memrealtime(), dt = (unsigned long long)pc[1]; while (__builtin_amdgcn_s_memrealtime() - t0 < dt) __builtin_amdgcn_s_sleep(8); }
    }
#endif
#undef IN
#undef SEAM
}

extern "C" void kernel_launch(void* const* d_in, const int* in_sizes, int n_in, void* d_out, int out_size, void* d_ws, size_t ws_size, hipStream_t stream) {
    static int grid = 0;
    if (grid == 0) {
        if (n_in != 28 || in_sizes[0] != NTOK * DM || out_size != NTOK * DM || ws_size < WS_NEED) {
            fprintf(stderr, "kernel_launch: unexpected shapes (n_in %d, in0 %d, out %d, ws %zu); nothing launched\n", n_in, n_in > 0 ? in_sizes[0] : -1, out_size, ws_size); grid = -1; return; }
        int dev = 0, cus = 0, per_cu = 0;
        (void)hipGetDevice(&dev); (void)hipDeviceGetAttribute(&cus, hipDeviceAttributeMultiprocessorCount, dev);
        (void)hipFuncSetAttribute((const void*)hybrid_fwd, hipFuncAttributeMaxDynamicSharedMemorySize, LDS_BYTES);
        (void)hipOccupancyMaxActiveBlocksPerMultiprocessor(&per_cu, (const void*)hybrid_fwd, 512, LDS_BYTES);
        if (per_cu < 1) { fprintf(stderr, "kernel_launch: occupancy query reports %d workgroups per CU\n", per_cu); }
        (void)hipGetLastError();
        grid = cus > 0 ? cus : 256;
    }
    if (grid < 0) return;
    (void)hipMemsetAsync((char*)d_ws + WS_CTL, 0, CTL_ZERO_BYTES, stream);
    Args a{};
    for (int i = 0; i < 28; ++i) a.in[i] = d_in[i];
    a.out = (float*)d_out; a.ws = (unsigned char*)d_ws;
    for (int i = 0; i < 32; ++i) a.invf[i] = (float)pow(10000.0, -(double)(2 * i) / 64.0);
#if MK_PER_PHASE
    for (int p = 0; p < NPHASE; ++p) { a.ph_lo = p; a.ph_hi = p + 1; void* kargs[] = {&a};
        hipError_t e = hipLaunchCooperativeKernel((const void*)hybrid_fwd, dim3(grid), dim3(512), kargs, LDS_BYTES, stream);
        if (e != hipSuccess) { fprintf(stderr, "kernel_launch: launch of phase %d failed: %s\n", p, hipGetErrorString(e)); break; } }
#else
    a.ph_lo = 0; a.ph_hi = NPHASE; void* kargs[] = {&a};
    hipError_t e = hipLaunchCooperativeKernel((const void*)hybrid_fwd, dim3(grid), dim3(512), kargs, LDS_BYTES, stream);
    if (e != hipSuccess) fprintf(stderr, "kernel_launch: cooperative launch failed: %s (grid %d)\n", hipGetErrorString(e), grid);
#endif
}
```
